# Optimizing an MI355X kernel written in HIP

```python
import math
import jax
import jax.numpy as jnp
from jax import lax
import numpy as np

D_MODEL = 1024
BATCH = 4
SEQ = 4096
DEPTH = 1
DEC_BATCH = 128
DEC_SEQ = 8
PAST_LEN = 8192
PAGE_SIZE = 128

HEAD_DIM = 64
ATT_WIDTH = D_MODEL // 2
ATT_HEADS = ATT_WIDTH // HEAD_DIM
ATT_KV_HEADS = ATT_HEADS // 4
ATT_GROUP = ATT_HEADS // ATT_KV_HEADS
KV_WIDTH = ATT_KV_HEADS * HEAD_DIM
WINDOW = 128
MLSTM_WIDTH = D_MODEL - ATT_WIDTH
MLSTM_DV = 128
MLSTM_HEADS = MLSTM_WIDTH // MLSTM_DV
MLSTM_DK = MLSTM_DV // 2
MQK_WIDTH = MLSTM_HEADS * MLSTM_DK
MLSTM_CHUNK = 64
MIX_WIDTH = ATT_WIDTH + MLSTM_WIDTH
IN_WIDTH = ATT_WIDTH + 2 * KV_WIDTH + 2 * MQK_WIDTH + 2 * MLSTM_WIDTH + 2 * MLSTM_HEADS
MEM_TOKENS = 256
CROSS_HEADS = 4
CROSS_HEAD_DIM = 64
CROSS_WIDTH = CROSS_HEADS * CROSS_HEAD_DIM
FFN_HIDDEN = -(-(8 * D_MODEL) // (3 * 256)) * 256
FORGET_BIAS = 3.0
EPS = 1e-6

kernel_name = "hymba_swa_sink_mlstm_decoder_step"


def rmsnorm(x, g):
    xf = x.astype(jnp.float32)
    y = xf * lax.rsqrt(jnp.mean(xf * xf, axis=-1, keepdims=True) + EPS)
    return (y * g.astype(jnp.float32)).astype(x.dtype)


def project_mixers(xn, w_in, b_igate, b_fgate):
    B, T, _ = xn.shape
    f32 = jnp.float32
    z = jnp.einsum('btd,de->bte', xn, w_in)
    sizes = (ATT_WIDTH, KV_WIDTH, KV_WIDTH, MQK_WIDTH, MQK_WIDTH, MLSTM_WIDTH, MLSTM_WIDTH,
             MLSTM_HEADS, MLSTM_HEADS)
    points = []
    acc = 0
    for s in sizes[:-1]:
        acc += s
        points.append(acc)
    q, k, v, mq, mk, mv, og, ig, fg = jnp.split(z, points, axis=-1)
    q = q.reshape(B, T, ATT_KV_HEADS, ATT_GROUP, HEAD_DIM)
    k = k.reshape(B, T, ATT_KV_HEADS, HEAD_DIM)
    v = v.reshape(B, T, ATT_KV_HEADS, HEAD_DIM)
    mq = mq.astype(f32).reshape(B, T, MLSTM_HEADS, MLSTM_DK)
    mk = mk.astype(f32).reshape(B, T, MLSTM_HEADS, MLSTM_DK) * (MLSTM_DK ** -0.5)
    mv = mv.astype(f32).reshape(B, T, MLSTM_HEADS, MLSTM_DV)
    ig = ig.astype(f32) + b_igate.astype(f32)
    lf = jax.nn.log_sigmoid(fg.astype(f32) + b_fgate.astype(f32))
    return q, k, v, mq, mk, mv, og, ig, lf


def window_mask(qpos, kpos):
    d = qpos[:, :, None] - kpos[:, None, :]
    return (d >= 0) & (d <= WINDOW)


def attend_with_sinks(q, k, v, mask, sinks):
    s = jnp.einsum('bnqhgd,bnkhd->bnhgqk', q, k).astype(jnp.float32) * (HEAD_DIM ** -0.5)
    s = jnp.where(mask[None, :, None, None], s, -jnp.inf)
    sink = sinks.astype(jnp.float32).reshape(1, 1, ATT_KV_HEADS, ATT_GROUP, 1, 1)
    m = jnp.maximum(jnp.max(s, axis=-1, keepdims=True), sink)
    p = jnp.exp(s - m)
    p = p / (jnp.sum(p, axis=-1, keepdims=True) + jnp.exp(sink - m))
    return jnp.einsum('bnhgqk,bnkhd->bnqhgd', p.astype(v.dtype), v)


def swa_prompt(q, k, v, sinks):
    B, T = q.shape[:2]
    nb = T // WINDOW
    qb = q.reshape(B, nb, WINDOW, ATT_KV_HEADS, ATT_GROUP, HEAD_DIM)

    def band(a):
        ab = a.reshape(B, nb, WINDOW, ATT_KV_HEADS, HEAD_DIM)
        prev = jnp.pad(ab[:, :-1], ((0, 0), (1, 0), (0, 0), (0, 0), (0, 0)))
        return jnp.concatenate([prev, ab], axis=2)

    start = jnp.arange(nb)[:, None] * WINDOW
    qpos = start + jnp.arange(WINDOW)[None, :]
    kpos = start - WINDOW + jnp.arange(2 * WINDOW)[None, :]
    mask = window_mask(qpos, kpos) & (kpos >= 0)[:, None, :]
    o = attend_with_sinks(qb, band(k), band(v), mask, sinks)
    return o.reshape(B, T, ATT_WIDTH)


def swa_sample(q, k, v, buf_k, buf_v, sinks):
    B, T = q.shape[:2]
    P = buf_k.shape[1]
    kc = jnp.concatenate([buf_k.astype(k.dtype), k], axis=1)
    vc = jnp.concatenate([buf_v.astype(v.dtype), v], axis=1)
    qpos = jnp.arange(T)[None, :]
    kpos = (jnp.arange(P + T) - P)[None, :]
    mask = window_mask(qpos, kpos)
    o = attend_with_sinks(q[:, None], kc[:, None], vc[:, None], mask, sinks)
    return o.reshape(B, T, ATT_WIDTH), kc[:, T:], vc[:, T:]


def mlstm_chunk(carry, inp):
    C, n, m = carry
    q, k, v, ig, lf = inp
    L = q.shape[1]
    bt = jnp.swapaxes(jnp.cumsum(lf, axis=1), 1, 2)
    it = jnp.swapaxes(ig, 1, 2)
    causal = jnp.tril(jnp.ones((L, L), dtype=bool))
    D = jnp.where(causal, bt[..., :, None] - bt[..., None, :] + it[..., None, :], -jnp.inf)
    inter = bt + m[..., None]
    mt = jnp.maximum(jnp.max(D, axis=-1), inter)
    S = jnp.einsum('blhd,bshd->bhls', q, k) * jnp.exp(D - mt[..., None])
    wi = jnp.exp(inter - mt)
    num = (jnp.einsum('bhls,bshe->blhe', S, v)
           + jnp.swapaxes(wi, 1, 2)[..., None] * jnp.einsum('blhd,bhed->blhe', q, C))
    den = jnp.sum(S, axis=-1) + wi * jnp.einsum('blhd,bhd->bhl', q, n)
    lower = jnp.maximum(jnp.abs(den), jnp.exp(-mt))
    h = num / jnp.swapaxes(lower, 1, 2)[..., None]
    bL = bt[..., -1]
    m_new = mt[..., -1]
    wk = jnp.exp(bL[..., None] - bt + it - m_new[..., None])
    wc = jnp.exp(bL + m - m_new)
    C_new = wc[..., None, None] * C + jnp.einsum('bhs,bshe,bshd->bhed', wk, v, k)
    n_new = wc[..., None] * n + jnp.einsum('bhs,bshd->bhd', wk, k)
    return (C_new, n_new, m_new), h


def mlstm_prompt(mq, mk, mv, ig, lf):
    B, T = mq.shape[:2]
    nc = T // MLSTM_CHUNK

    def chunks(a):
        return jnp.moveaxis(a.reshape(B, nc, MLSTM_CHUNK, *a.shape[2:]), 1, 0)

    init = (jnp.zeros((B, MLSTM_HEADS, MLSTM_DV, MLSTM_DK), jnp.float32),
            jnp.zeros((B, MLSTM_HEADS, MLSTM_DK), jnp.float32),
            jnp.zeros((B, MLSTM_HEADS), jnp.float32))
    (C, n, m), h = lax.scan(mlstm_chunk, init,
                            (chunks(mq), chunks(mk), chunks(mv), chunks(ig), chunks(lf)))
    h = jnp.moveaxis(h, 0, 1).reshape(B, T, MLSTM_HEADS, MLSTM_DV)
    return h, C, n, m


def merge_mixers(att, h, og, g_head, w_out):
    B, T = h.shape[:2]
    hn = h * lax.rsqrt(jnp.mean(h * h, axis=-1, keepdims=True) + EPS)
    hm = hn.reshape(B, T, MLSTM_WIDTH) * g_head.astype(jnp.float32) * jax.nn.sigmoid(og.astype(jnp.float32))
    cat = jnp.concatenate([att, hm.astype(att.dtype)], axis=-1)
    return jnp.einsum('bte,ed->btd', cat, w_out)


def memory_kv(mem, g_mem, w_ck, w_cv):
    B, M, _ = mem.shape
    mn = rmsnorm(mem, g_mem)
    k = jnp.einsum('bmd,de->bme', mn, w_ck).reshape(B, M, CROSS_HEADS, CROSS_HEAD_DIM)
    v = jnp.einsum('bmd,de->bme', mn, w_cv).reshape(B, M, CROSS_HEADS, CROSS_HEAD_DIM)
    return k, v


def cross_attend(xn, mk, mv, w_cq, w_co):
    B, T, _ = xn.shape
    q = jnp.einsum('btd,de->bte', xn, w_cq).reshape(B, T, CROSS_HEADS, CROSS_HEAD_DIM)
    s = jnp.einsum('bthd,bmhd->bhtm', q, mk.astype(q.dtype)).astype(jnp.float32) * (CROSS_HEAD_DIM ** -0.5)
    p = jax.nn.softmax(s, axis=-1)
    o = jnp.einsum('bhtm,bmhd->bthd', p.astype(q.dtype), mv.astype(q.dtype))
    return jnp.einsum('bte,ed->btd', o.reshape(B, T, CROSS_WIDTH), w_co)


def swiglu(xn, w_gate, w_up, w_down):
    g = jnp.einsum('btd,df->btf', xn, w_gate)
    u = jnp.einsum('btd,df->btf', xn, w_up)
    return jnp.einsum('btf,fd->btd', jax.nn.silu(g) * u, w_down)


def setup_inputs(seed: int = 0) -> dict:
    key = jax.random.key(seed)
    ks = jax.random.split(key, 32)
    f32 = jnp.float32

    def nrm(k, shape, scale):
        return jax.random.normal(k, shape, f32) * scale

    buf = min(WINDOW, PAST_LEN)
    D = D_MODEL
    return {
        "x_prompt": nrm(ks[0], (BATCH, SEQ, D), 1.0),
        "x_sample": nrm(ks[1], (DEC_BATCH, DEC_SEQ, D), 1.0),
        "mem_prompt": nrm(ks[2], (BATCH, MEM_TOKENS, D), 1.0),
        "cache_swa_k": nrm(ks[3], (DEPTH, DEC_BATCH, buf, ATT_KV_HEADS, HEAD_DIM), 1.0),
        "cache_swa_v": nrm(ks[4], (DEPTH, DEC_BATCH, buf, ATT_KV_HEADS, HEAD_DIM), 1.0),
        "state_mlstm_C": nrm(ks[5], (DEPTH, DEC_BATCH, MLSTM_HEADS, MLSTM_DV, MLSTM_DK), 0.3),
        "state_mlstm_n": nrm(ks[6], (DEPTH, DEC_BATCH, MLSTM_HEADS, MLSTM_DK), 0.3),
        "state_mlstm_m": nrm(ks[7], (DEPTH, DEC_BATCH, MLSTM_HEADS), 1.0),
        "cache_mem_k": nrm(ks[8], (DEPTH, DEC_BATCH, MEM_TOKENS, CROSS_HEADS, CROSS_HEAD_DIM), 1.0),
        "cache_mem_v": nrm(ks[9], (DEPTH, DEC_BATCH, MEM_TOKENS, CROSS_HEADS, CROSS_HEAD_DIM), 1.0),
        "w_in": nrm(ks[10], (DEPTH, D, IN_WIDTH), D ** -0.5),
        "b_igate": nrm(ks[11], (DEPTH, MLSTM_HEADS), 0.1),
        "b_fgate": FORGET_BIAS + nrm(ks[12], (DEPTH, MLSTM_HEADS), 0.1),
        "attn_sinks": nrm(ks[13], (DEPTH, ATT_HEADS), 0.5),
        "g_mlstm_head": 1.0 + nrm(ks[14], (DEPTH, MLSTM_WIDTH), 0.05),
        "w_out": nrm(ks[15], (DEPTH, MIX_WIDTH, D), MIX_WIDTH ** -0.5),
        "g_mix": 1.0 + nrm(ks[16], (DEPTH, D), 0.05),
        "g_cross": 1.0 + nrm(ks[17], (DEPTH, D), 0.05),
        "g_mem": 1.0 + nrm(ks[18], (DEPTH, D), 0.05),
        "w_cq": nrm(ks[19], (DEPTH, D, CROSS_WIDTH), D ** -0.5),
        "w_ck": nrm(ks[20], (DEPTH, D, CROSS_WIDTH), D ** -0.5),
        "w_cv": nrm(ks[21], (DEPTH, D, CROSS_WIDTH), D ** -0.5),
        "w_co": nrm(ks[22], (DEPTH, CROSS_WIDTH, D), CROSS_WIDTH ** -0.5),
        "g_ffn": 1.0 + nrm(ks[23], (DEPTH, D), 0.05),
        "w_gate": nrm(ks[24], (DEPTH, D, FFN_HIDDEN), D ** -0.5),
        "w_up": nrm(ks[25], (DEPTH, D, FFN_HIDDEN), D ** -0.5),
        "w_down": nrm(ks[26], (DEPTH, FFN_HIDDEN, D), FFN_HIDDEN ** -0.5),
        "g_final": 1.0 + nrm(ks[27], (D,), 0.05),
    }


def reference(x_prompt, x_sample, mem_prompt, cache_swa_k, cache_swa_v, state_mlstm_C,
              state_mlstm_n, state_mlstm_m, cache_mem_k, cache_mem_v, w_in, b_igate, b_fgate,
              attn_sinks, g_mlstm_head, w_out, g_mix, g_cross, g_mem, w_cq, w_ck, w_cv, w_co,
              g_ffn, w_gate, w_up, w_down, g_final):
    f32 = jnp.float32
    yp, ys = x_prompt, x_sample
    skp, svp, Cp, np_, mp, mkp, mvp = [], [], [], [], [], [], []
    sks, svs, Cs, ns, ms = [], [], [], [], []
    for l in range(DEPTH):
        q, k, v, mq, mk, mv, og, ig, lf = project_mixers(rmsnorm(yp, g_mix[l]), w_in[l], b_igate[l], b_fgate[l])
        att = swa_prompt(q, k, v, attn_sinks[l])
        h, C, n, m = mlstm_prompt(mq, mk, mv, ig, lf)
        yp = yp + merge_mixers(att, h, og, g_mlstm_head[l], w_out[l])
        skp.append(k[:, -WINDOW:])
        svp.append(v[:, -WINDOW:])
        Cp.append(C)
        np_.append(n)
        mp.append(m)
        q, k, v, mq, mk, mv, og, ig, lf = project_mixers(rmsnorm(ys, g_mix[l]), w_in[l], b_igate[l], b_fgate[l])
        att, kbuf, vbuf = swa_sample(q, k, v, cache_swa_k[l], cache_swa_v[l], attn_sinks[l])
        carry = (state_mlstm_C[l].astype(f32), state_mlstm_n[l].astype(f32), state_mlstm_m[l].astype(f32))
        (C, n, m), h = mlstm_chunk(carry, (mq, mk, mv, ig, lf))
        ys = ys + merge_mixers(att, h, og, g_mlstm_head[l], w_out[l])
        sks.append(kbuf)
        svs.append(vbuf)
        Cs.append(C)
        ns.append(n)
        ms.append(m)
        memk, memv = memory_kv(mem_prompt, g_mem[l], w_ck[l], w_cv[l])
        yp = yp + cross_attend(rmsnorm(yp, g_cross[l]), memk, memv, w_cq[l], w_co[l])
        ys = ys + cross_attend(rmsnorm(ys, g_cross[l]), cache_mem_k[l], cache_mem_v[l], w_cq[l], w_co[l])
        mkp.append(memk)
        mvp.append(memv)
        yp = yp + swiglu(rmsnorm(yp, g_ffn[l]), w_gate[l], w_up[l], w_down[l])
        ys = ys + swiglu(rmsnorm(ys, g_ffn[l]), w_gate[l], w_up[l], w_down[l])
    y_prompt = rmsnorm(yp, g_final)
    y_sample = rmsnorm(ys, g_final)
    return (y_prompt, y_sample,
            jnp.stack(skp), jnp.stack(svp), jnp.stack(Cp), jnp.stack(np_), jnp.stack(mp),
            jnp.stack(mkp), jnp.stack(mvp),
            jnp.stack(sks), jnp.stack(svs), jnp.stack(Cs), jnp.stack(ns), jnp.stack(ms))
```

```cpp
#include <hip/hip_runtime.h>
#include <hip/hip_cooperative_groups.h>
#include <cstdio>
#include <cstdint>
namespace cg = cooperative_groups;

#define LAS __attribute__((address_space(3)))
typedef unsigned short bf16_t;
typedef short bf16x8 __attribute__((ext_vector_type(8)));
typedef short bf16x4 __attribute__((ext_vector_type(4)));
typedef float f32x4 __attribute__((ext_vector_type(4)));
typedef float f32x16 __attribute__((ext_vector_type(16)));
typedef unsigned u32x4 __attribute__((ext_vector_type(4)));
typedef unsigned u32x2 __attribute__((ext_vector_type(2)));

constexpr int D = 1024, MP = 16384, MS = 1024, M = MP + MS, SEQ = 4096;
constexpr int INW = 2312, ZW = 2304, FFN = 2816;
constexpr int ZQ = 0, ZK = 512, ZV = 640, ZMQ = 768, ZMK = 1024, ZMV = 1280, ZOG = 1792;
constexpr int NUNIT = 1024;
constexpr size_t O_Y = 0, O_SKP = (size_t)M * D, O_SVP = O_SKP + 65536, O_CP = O_SVP + 65536, O_NP = O_CP + 131072, O_MP = O_NP + 1024,
                 O_MKP = O_MP + 16, O_MVP = O_MKP + 262144, O_SKS = O_MVP + 262144, O_SVS = O_SKS + 2097152, O_CS = O_SVS + 2097152,
                 O_NS = O_CS + 4194304, O_MS = O_NS + 32768, O_END = O_MS + 512;
constexpr size_t al256(size_t x) { return (x + 255) & ~(size_t)255; }
constexpr size_t WS_WIN = 0;
constexpr size_t WS_WOUT = WS_WIN + (size_t)ZW * D * 2;
constexpr size_t WS_WCQ = WS_WOUT + (size_t)D * D * 2;
constexpr size_t WS_WCKV = WS_WCQ + (size_t)256 * D * 2;
constexpr size_t WS_WCO = WS_WCKV + (size_t)512 * D * 2;
constexpr size_t WS_WGU = WS_WCO + (size_t)D * 256 * 2;
constexpr size_t WS_WD = WS_WGU + (size_t)2 * FFN * D * 2;
constexpr size_t WS_XN = WS_WD + (size_t)D * FFN * 2;
constexpr size_t WS_MN = WS_XN + (size_t)M * D * 2;
constexpr size_t WS_GATES = WS_MN + (size_t)1024 * D * 2;
constexpr size_t WS_MEMKV = WS_GATES + (size_t)M * 8 * 4;
constexpr size_t WS_SCAL = WS_MEMKV + (size_t)1024 * 512 * 2;
constexpr size_t WS_NT = WS_SCAL + 3 * 4096;
constexpr size_t WS_NPREV = WS_NT + (size_t)NUNIT * 64 * 4;
constexpr size_t WS_Z = WS_NPREV + (size_t)NUNIT * 64 * 4;
constexpr size_t WS_CAT = WS_Z + (size_t)M * ZW * 2;
constexpr size_t WS_H = WS_Z;
constexpr size_t WS_UT = WS_CAT + (size_t)M * D * 2;
constexpr size_t WS_Q2 = WS_UT;
constexpr size_t WS_O2 = WS_Q2 + (size_t)M * 256 * 2;
constexpr size_t WS_SLAB = WS_UT;
constexpr size_t WS_CPREV = WS_UT + (size_t)NUNIT * 8192 * 4;
constexpr size_t WS_BAR = WS_CPREV + (size_t)NUNIT * 8192 * 2;
constexpr size_t WS_SSQ1 = WS_BAR + 16384;
constexpr size_t WS_SSQ2 = WS_SSQ1 + (size_t)M * 4;
constexpr size_t WS_DEP = WS_SSQ2 + (size_t)M * 4;
constexpr size_t WS_ZERO_BYTES = 16384 + 2 * (size_t)M * 4 + 256;
constexpr size_t WS_END = WS_DEP + 256;
static_assert((size_t)M * FFN * 2 <= (size_t)M * ZW * 2 + (size_t)M * D * 2, "H overlay");
static_assert(WS_END <= (size_t)256 * 1024 * 1024, "workspace");
static_assert((size_t)11 * MS * D * 4 <= (size_t)NUNIT * 8192 * 4 + (size_t)NUNIT * 8192 * 2, "slab overlay");

constexpr int LDS_BYTES = 140 * 1024;
constexpr int NTHREADS = 512;

struct Params {
    const float *x_prompt, *x_sample, *mem_prompt, *cache_swa_k, *cache_swa_v, *st_C, *st_n, *st_m, *cache_mem_k, *cache_mem_v,
        *w_in, *b_ig, *b_fg, *sinks, *g_head, *w_out, *g_mix, *g_cross, *g_mem, *w_cq, *w_ck, *w_cv, *w_co, *g_ffn, *w_gate, *w_up, *w_down, *g_final;
    float* out;
    unsigned char* ws;
};

__device__ __forceinline__ unsigned pk_bf16(float lo, float hi) { unsigned r; asm volatile("v_cvt_pk_bf16_f32 %0, %1, %2" : "=v"(r) : "v"(lo), "v"(hi)); return r; }
__device__ __forceinline__ float bf_lo(unsigned u) { return __uint_as_float(u << 16); }
__device__ __forceinline__ float bf_hi(unsigned u) { return __uint_as_float(u & 0xffff0000u); }
__device__ __forceinline__ float bf2f(bf16_t b) { return __uint_as_float(((unsigned)b) << 16); }
__device__ __forceinline__ const float* xrow(const Params& p, int r) { return r < MP ? p.x_prompt + (size_t)r * D : p.x_sample + (size_t)(r - MP) * D; }
__device__ __forceinline__ int opaque_tid() { int t = threadIdx.x; asm volatile("" : "+v"(t)); return t; }
__device__ __forceinline__ float wave_sum(float v) {
#pragma unroll
    for (int o = 32; o > 0; o >>= 1) v += __shfl_xor(v, o);
    return v;
}
__device__ __forceinline__ float wave_max(float v) {
#pragma unroll
    for (int o = 32; o > 0; o >>= 1) v = fmaxf(v, __shfl_xor(v, o));
    return v;
}
__device__ __forceinline__ float wave_scan_add(float v, int lane) {
#pragma unroll
    for (int o = 1; o < 64; o <<= 1) { float t = __shfl_up(v, o); if (lane >= o) v += t; }
    return v;
}
__device__ __forceinline__ float wave_scan_max(float v, int lane) {
#pragma unroll
    for (int o = 1; o < 64; o <<= 1) { float t = __shfl_up(v, o); if (lane >= o) v = fmaxf(v, t); }
    return v;
}

namespace pg8 {
constexpr int BM = 256, BK = 64, HALF = 128, HTB = HALF * BK * 2, STAGE_BYTES = 8 * HTB, NXCD = 8, WGM = 8;
__device__ __forceinline__ int lds_byte(int r, int c) { const int st = (r >> 4) * 2 + (c >> 5), rr = r & 15, cc = c & 31, ob = rr * 64 + cc * 2; return st * 1024 + (ob ^ (((ob >> 9) & 1) << 5)); }
__device__ __forceinline__ void stage_rc(int b, int& R, int& C) { const int st = b / 1024, sb = b % 1024, swz = sb ^ (((sb >> 9) & 1) << 5); R = (st >> 1) * 16 + swz / 64; C = (st & 1) * 32 + (swz % 64) / 2; }
__device__ __forceinline__ int perm32(int rho) { const int n = rho >> 4, i = rho & 15; return 8 * (i >> 2) + 4 * n + (i & 3); }
struct Unit { int pm, pn; };
struct Gemm { const bf16_t* A; const bf16_t* Bt; int M, N, K, ld; };
struct StaticOrder {
    int nM, nN, nwg, G, c, spm, spn;
    __device__ void init(int M_, int N_, int G_, int c_) { nM = M_ / BM; nN = N_ / BM; nwg = nM * nN; G = G_; c = c_; spm = -1; spn = 0; }
    __device__ bool next(int i, Unit& u) const {
        if (spm >= 0) { if (i > 0 || c < 0) return false; u.pm = spm; u.pn = spn; return true; }
        const long L = (long)i * G + c; if (L >= nwg) return false;
        int wgid = (int)L; { const int q = nwg / NXCD, r = nwg % NXCD, xcd = wgid % NXCD, off = wgid / NXCD; wgid = (xcd < r ? xcd * (q + 1) : r * (q + 1) + (xcd - r) * q) + off; }
        const int nig = WGM * nN, gid = wgid / nig, fm = gid * WGM, gsz = (nM - fm) < WGM ? (nM - fm) : WGM;
        u.pm = fm + ((wgid % nig) % gsz); u.pn = (wgid % nig) / gsz; return true;
    }
};
}

enum { EM_BF16 = 0, EM_SWIGLU = 1, EM_RES_X = 2, EM_RES_Y = 3, EM_MEMKV = 4, EM_DUMMY = 5, EM_SLAB = 6 };
struct Epi {
    int mode, perm, ldc;
    bf16_t* O;
    float* Y;
    unsigned* dep;
    float* ssq;
};

__device__ __forceinline__ float silu_f(float g) { return g * __builtin_amdgcn_rcpf(1.0f + __expf(-g)); }

__device__ __forceinline__ void epi_apply(const Params& p, const Epi& E, const f32x4 (&acc)[2][2][4][2], const pg8::Unit& u, int wr, int wc, int fr, int fq) {
    const int row0 = u.pm * 256 + wr * 64 + fr;
    if (E.mode == EM_BF16) {
        const int col0 = u.pn * 256 + wc * 32 + 8 * fq;
        float rsv[2][4];
#pragma unroll
        for (int ai = 0; ai < 2; ++ai)
#pragma unroll
            for (int m = 0; m < 4; ++m) rsv[ai][m] = E.ssq ? E.ssq[row0 + ai * 128 + m * 16] : 0.f;
#pragma unroll
        for (int ai = 0; ai < 2; ++ai)
#pragma unroll
            for (int m = 0; m < 4; ++m) {
                bf16_t* rowp = E.O + (size_t)(row0 + ai * 128 + m * 16) * E.ldc + col0;
                const float rs = E.ssq ? rsqrtf(rsv[ai][m] * (1.0f / D) + 1e-6f) : 1.0f;
#pragma unroll
                for (int bj = 0; bj < 2; ++bj) {
                    const f32x4 v0 = acc[ai][bj][m][0] * rs, v1 = acc[ai][bj][m][1] * rs;
                    u32x4 o; o[0] = pk_bf16(v0[0], v0[1]); o[1] = pk_bf16(v0[2], v0[3]); o[2] = pk_bf16(v1[0], v1[1]); o[3] = pk_bf16(v1[2], v1[3]);
                    *(u32x4*)(rowp + bj * 128) = o;
                }
            }
    } else if (E.mode == EM_SWIGLU) {
        const int col0 = u.pn * 128 + wc * 32 + 8 * fq;
        float rsv[2][4];
#pragma unroll
        for (int ai = 0; ai < 2; ++ai)
#pragma unroll
            for (int m = 0; m < 4; ++m) rsv[ai][m] = E.ssq ? E.ssq[row0 + ai * 128 + m * 16] : 0.f;
#pragma unroll
        for (int ai = 0; ai < 2; ++ai)
#pragma unroll
            for (int m = 0; m < 4; ++m) {
                bf16_t* rowp = E.O + (size_t)(row0 + ai * 128 + m * 16) * E.ldc + col0;
                const float rs = E.ssq ? rsqrtf(rsv[ai][m] * (1.0f / D) + 1e-6f) : 1.0f;
                const f32x4 g0 = acc[ai][0][m][0] * rs, g1 = acc[ai][0][m][1] * rs, u0 = acc[ai][1][m][0] * rs, u1 = acc[ai][1][m][1] * rs;
                u32x4 o;
                o[0] = pk_bf16(silu_f(g0[0]) * u0[0], silu_f(g0[1]) * u0[1]); o[1] = pk_bf16(silu_f(g0[2]) * u0[2], silu_f(g0[3]) * u0[3]);
                o[2] = pk_bf16(silu_f(g1[0]) * u1[0], silu_f(g1[1]) * u1[1]); o[3] = pk_bf16(silu_f(g1[2]) * u1[2], silu_f(g1[3]) * u1[3]);
                *(u32x4*)rowp = o;
            }
    } else if (E.mode == EM_RES_X || E.mode == EM_RES_Y) {
        const int col0 = u.pn * 256 + wc * 32 + 4 * fq;
        float ssr[2][4];
#pragma unroll
        for (int ai = 0; ai < 2; ++ai) {
            f32x4 rr[4][2][2];
#pragma unroll
            for (int m = 0; m < 4; ++m) {
                const int row = row0 + ai * 128 + m * 16;
                if (E.mode == EM_RES_X) {
                    const float* rp = xrow(p, row) + col0;
#pragma unroll
                    for (int bj = 0; bj < 2; ++bj)
#pragma unroll
                        for (int n = 0; n < 2; ++n) rr[m][bj][n] = *(const f32x4*)(rp + bj * 128 + n * 16);
                } else {
                    const bf16_t* rp = E.O + (size_t)row * D + col0;
#pragma unroll
                    for (int bj = 0; bj < 2; ++bj)
#pragma unroll
                        for (int n = 0; n < 2; ++n) { const u32x2 q = *(const u32x2*)(rp + bj * 128 + n * 16); rr[m][bj][n] = (f32x4){bf_lo(q[0]), bf_hi(q[0]), bf_lo(q[1]), bf_hi(q[1])}; }
                }
            }
#pragma unroll
            for (int m = 0; m < 4; ++m) {
                const int row = row0 + ai * 128 + m * 16;
                float ss = 0.f;
#pragma unroll
                for (int bj = 0; bj < 2; ++bj)
#pragma unroll
                    for (int n = 0; n < 2; ++n) {
                        const f32x4 y = acc[ai][bj][m][n] + rr[m][bj][n];
                        if (E.Y) *(f32x4*)(E.Y + (size_t)row * D + col0 + bj * 128 + n * 16) = y;
                        else { u32x2 o; o[0] = pk_bf16(y[0], y[1]); o[1] = pk_bf16(y[2], y[3]); *(u32x2*)(E.O + (size_t)row * D + col0 + bj * 128 + n * 16) = o; }
                        ss += y[0] * y[0] + y[1] * y[1] + y[2] * y[2] + y[3] * y[3];
                    }
                ssr[ai][m] = ss;
            }
        }
        if (E.ssq) {
#pragma unroll
            for (int ai = 0; ai < 2; ++ai)
#pragma unroll
                for (int m = 0; m < 4; ++m) { float ss = ssr[ai][m]; ss += __shfl_xor(ss, 16); ss += __shfl_xor(ss, 32);
                    if (fq == 0) (void)__hip_atomic_fetch_add(E.ssq + row0 + ai * 128 + m * 16, ss, __ATOMIC_RELAXED, __HIP_MEMORY_SCOPE_AGENT); }
        }
    } else if (E.mode == EM_SLAB) {
        const int col0 = u.pn * 256 + wc * 32 + 4 * fq;
#pragma unroll
        for (int ai = 0; ai < 2; ++ai)
#pragma unroll
            for (int m = 0; m < 4; ++m) {
                bf16_t* yp = (bf16_t*)E.Y + (size_t)(row0 - MP + ai * 128 + m * 16) * D + col0;
#pragma unroll
                for (int bj = 0; bj < 2; ++bj)
#pragma unroll
                    for (int n = 0; n < 2; ++n) { const f32x4 a = acc[ai][bj][m][n]; u32x2 o; o[0] = pk_bf16(a[0], a[1]); o[1] = pk_bf16(a[2], a[3]); *(u32x2*)(yp + bj * 128 + n * 16) = o; }
            }
    } else if (E.mode == EM_DUMMY) {
        if (acc[0][0][0][0][0] == 12345.678f && acc[1][1][3][1][3] == -777.25f) E.Y[row0] = acc[0][1][2][0][1];
    } else {
        const int col0 = u.pn * 256 + wc * 32 + 4 * fq;
        float* ob = p.out + (u.pn == 0 ? O_MKP : O_MVP);
#pragma unroll
        for (int ai = 0; ai < 2; ++ai)
#pragma unroll
            for (int m = 0; m < 4; ++m) {
                const int row = row0 + ai * 128 + m * 16;
#pragma unroll
                for (int bj = 0; bj < 2; ++bj)
#pragma unroll
                    for (int n = 0; n < 2; ++n) {
                        const int c = col0 + bj * 128 + n * 16;
                        const f32x4 v = acc[ai][bj][m][n];
                        *(f32x4*)(ob + (size_t)row * 256 + (c & 255)) = v;
                        u32x2 o; o[0] = pk_bf16(v[0], v[1]); o[1] = pk_bf16(v[2], v[3]);
                        *(u32x2*)(E.O + (size_t)row * 512 + c) = o;
                    }
            }
    }
}

__device__ __forceinline__ void gemm_phase(const Params& p, LAS unsigned char* lds, const pg8::Gemm g, const pg8::StaticOrder& S, const Epi& E) {
    using namespace pg8;
    int tid_ = threadIdx.x; asm volatile("" : "+v"(tid_));
    const int tid = tid_, wid = __builtin_amdgcn_readfirstlane(tid >> 6), lane = tid & 63, wr = wid >> 2, wc = wid & 3, fr = lane & 15, fq = lane >> 4;
    const int K = g.K, nt = K / BK;
    unsigned voffA[2], voffB[2];
#pragma unroll
    for (int i = 0; i < 2; ++i) { int R, C; stage_rc(tid * 16 + i * 8192, R, C); const int Rb = E.perm ? ((R & ~31) + perm32(R & 31)) : R;
        voffA[i] = (unsigned)(R * g.ld + C) * 2u; voffB[i] = (unsigned)(Rb * g.ld + C) * 2u; }
    const size_t kstep = (size_t)(BK * 2);
    const size_t hstep = (size_t)HALF * g.ld * 2;
    const size_t tstep = 2 * hstep;
    const unsigned ldsw = (unsigned)wid * 1024u;
    const int aoff = lds_byte(wr * 64 + fr, fq * 8), boff = lds_byte(wc * 32 + fr, fq * 8);
#define PG8_SA(b, h) (((b) * 2 + (h)) * HTB)
#define PG8_SB(b, h) ((4 + (b) * 2 + (h)) * HTB)
#define PG8_STAGE(bufoff, gbase, voff) do { _Pragma("unroll") for (int _i = 0; _i < 2; ++_i) \
        __builtin_amdgcn_global_load_lds((const unsigned*)((const char*)(gbase) + (voff)[_i]), (LAS unsigned*)(lds + (bufoff) + ldsw + _i * 8192), 16, 0, 0); } while (0)
#define PG8_LDA(dst, b, h) do { _Pragma("unroll") for (int m = 0; m < 4; ++m) _Pragma("unroll") for (int k = 0; k < 2; ++k) dst[m][k] = *(const LAS bf16x8*)(lds + PG8_SA(b, h) + aoff + m * 2048 + k * 1024); } while (0)
#define PG8_LDB(dst, b, h) do { _Pragma("unroll") for (int n = 0; n < 2; ++n) _Pragma("unroll") for (int k = 0; k < 2; ++k) dst[n][k] = *(const LAS bf16x8*)(lds + PG8_SB(b, h) + boff + n * 2048 + k * 1024); } while (0)
#define PG8_MMA(ai, bj, At, Bt) do { __builtin_amdgcn_s_setprio(1); _Pragma("unroll") for (int m = 0; m < 4; ++m) _Pragma("unroll") for (int n = 0; n < 2; ++n) _Pragma("unroll") for (int k = 0; k < 2; ++k) \
        acc[ai][bj][m][n] = __builtin_amdgcn_mfma_f32_16x16x32_bf16(Bt[n][k], At[m][k], acc[ai][bj][m][n], 0, 0, 0); __builtin_amdgcn_s_setprio(0); } while (0)
#define PG8_WAIT_V(n) asm volatile("s_waitcnt vmcnt(" #n ")" ::: "memory")
#define PG8_WAIT_L(n) asm volatile("s_waitcnt lgkmcnt(" #n ")" ::: "memory")
#define PG8_BAR __builtin_amdgcn_s_barrier()
#define PG8_SCHED __builtin_amdgcn_sched_barrier(0)
    Unit cur, nxt; int ui = 0;
    if (!S.next(0, cur)) return;
#define PG8_DEPWAIT() do { unsigned _sp = 0; while ((unsigned)__builtin_amdgcn_readfirstlane((int)__hip_atomic_load(E.dep, __ATOMIC_RELAXED, __HIP_MEMORY_SCOPE_AGENT)) < 16u) { __builtin_amdgcn_s_sleep(4); if (++_sp > (1u << 18)) break; } \
        __builtin_amdgcn_fence(__ATOMIC_ACQUIRE, "agent"); asm volatile("s_waitcnt vmcnt(0)" ::: "memory"); } while (0)
    if (E.dep && cur.pm >= 64) PG8_DEPWAIT();
    f32x4 acc[2][2][4][2];
#pragma unroll
    for (int a = 0; a < 2; ++a)
#pragma unroll
        for (int b = 0; b < 2; ++b)
#pragma unroll
            for (int m = 0; m < 4; ++m)
#pragma unroll
                for (int n = 0; n < 2; ++n) acc[a][b][m][n] = (f32x4){0.f, 0.f, 0.f, 0.f};
    bf16x8 At[4][2], B0[2][2], B1[2][2];
    const char* cA = (const char*)g.A + (size_t)cur.pm * tstep; const char* cB = (const char*)g.Bt + (size_t)cur.pn * tstep;
    PG8_STAGE(PG8_SB(0, 0), cB, voffB); PG8_STAGE(PG8_SB(0, 1), cB + hstep, voffB); PG8_STAGE(PG8_SA(0, 0), cA, voffA); PG8_STAGE(PG8_SA(0, 1), cA + hstep, voffA);
    if (wr == 1) PG8_BAR;
    PG8_WAIT_V(2); PG8_BAR;
    PG8_STAGE(PG8_SB(1, 0), cB + kstep, voffB); PG8_STAGE(PG8_SA(1, 0), cA + kstep, voffA); PG8_STAGE(PG8_SB(1, 1), cB + hstep + kstep, voffB);
    PG8_WAIT_V(6); PG8_BAR;
    for (;;) {
        const bool has_next = S.next(ui + 1, nxt);
        if (E.dep && has_next && nxt.pm >= 64 && cur.pm < 64) PG8_DEPWAIT();
        const char* nA = has_next ? (const char*)g.A + (size_t)nxt.pm * tstep : cA; const char* nB = has_next ? (const char*)g.Bt + (size_t)nxt.pn * tstep : cB;
        for (int t = 0; t < nt; t += 2) {
            const bool last = (t == nt - 2);
            const char* a1 = cA + (size_t)(t + 1) * kstep;
            const char* a2 = last ? nA : cA + (size_t)(t + 2) * kstep; const char* b2 = last ? nB : cB + (size_t)(t + 2) * kstep;
            const char* a3 = a2 + kstep; const char* b3 = b2 + kstep;
            PG8_LDB(B0, 0, 0); PG8_LDB(B1, 0, 1); PG8_SCHED; PG8_LDA(At, 0, 0); PG8_STAGE(PG8_SA(1, 1), a1 + hstep, voffA);
            PG8_WAIT_V(8); PG8_WAIT_L(0); PG8_BAR; PG8_MMA(0, 0, At, B0); PG8_MMA(0, 1, At, B1); PG8_BAR; PG8_SCHED;
            PG8_LDA(At, 0, 1); PG8_STAGE(PG8_SB(0, 0), b2, voffB); PG8_STAGE(PG8_SB(0, 1), b2 + hstep, voffB); PG8_STAGE(PG8_SA(0, 0), a2, voffA);
            PG8_WAIT_V(8); PG8_WAIT_L(0); PG8_BAR; PG8_MMA(1, 0, At, B0); PG8_MMA(1, 1, At, B1); PG8_BAR; PG8_SCHED;
            PG8_LDB(B0, 1, 0); PG8_LDB(B1, 1, 1); PG8_SCHED; PG8_LDA(At, 1, 0); PG8_STAGE(PG8_SA(0, 1), a2 + hstep, voffA);
            PG8_WAIT_V(8); PG8_WAIT_L(0); PG8_BAR; PG8_MMA(0, 0, At, B0); PG8_MMA(0, 1, At, B1); PG8_BAR; PG8_SCHED;
            PG8_LDA(At, 1, 1); PG8_STAGE(PG8_SB(1, 0), b3, voffB); PG8_STAGE(PG8_SB(1, 1), b3 + hstep, voffB); PG8_STAGE(PG8_SA(1, 0), a3, voffA);
            PG8_WAIT_V(8); PG8_WAIT_L(0); PG8_BAR; PG8_MMA(1, 0, At, B0); PG8_MMA(1, 1, At, B1); PG8_BAR; PG8_SCHED;
        }
        if (wr == 0) PG8_BAR;
        epi_apply(p, E, acc, cur, wr, wc, fr, fq);
        if (!has_next) break;
#pragma unroll
        for (int a = 0; a < 2; ++a)
#pragma unroll
            for (int b = 0; b < 2; ++b)
#pragma unroll
                for (int m = 0; m < 4; ++m)
#pragma unroll
                    for (int n = 0; n < 2; ++n) acc[a][b][m][n] = (f32x4){0.f, 0.f, 0.f, 0.f};
        cur = nxt; cA = nA; cB = nB; ++ui;
        if (wr == 1) PG8_BAR;
    }
    PG8_WAIT_V(0);
    PG8_BAR;
#undef PG8_DEPWAIT
#undef PG8_SA
#undef PG8_SB
#undef PG8_STAGE
#undef PG8_LDA
#undef PG8_LDB
#undef PG8_MMA
#undef PG8_WAIT_V
#undef PG8_WAIT_L
#undef PG8_BAR
#undef PG8_SCHED
}

struct TileJob { const float* src; bf16_t* dst; const float* gk; int ld, dstK, k0, n0, dr0; };
__device__ __forceinline__ TileJob decode_tile(const Params& p, int t) {
    TileJob j; int nN, tt, job;
    if (t < 576) { job = 0; tt = t; j.src = p.w_in; j.ld = INW; nN = 36; j.dst = (bf16_t*)(p.ws + WS_WIN); j.dstK = 1024; }
    else if (t < 640) { job = 3; tt = t - 576; j.src = p.w_ck; j.ld = 256; nN = 4; j.dst = (bf16_t*)(p.ws + WS_WCKV); j.dstK = 1024; }
    else if (t < 704) { job = 4; tt = t - 640; j.src = p.w_cv; j.ld = 256; nN = 4; j.dst = (bf16_t*)(p.ws + WS_WCKV); j.dstK = 1024; }
    else if (t < 960) { job = 1; tt = t - 704; j.src = p.w_out; j.ld = 1024; nN = 16; j.dst = (bf16_t*)(p.ws + WS_WOUT); j.dstK = 1024; }
    else if (t < 1024) { job = 2; tt = t - 960; j.src = p.w_cq; j.ld = 256; nN = 4; j.dst = (bf16_t*)(p.ws + WS_WCQ); j.dstK = 1024; }
    else if (t < 1088) { job = 5; tt = t - 1024; j.src = p.w_co; j.ld = 1024; nN = 16; j.dst = (bf16_t*)(p.ws + WS_WCO); j.dstK = 256; }
    else if (t < 1792) { job = 6; tt = t - 1088; j.src = p.w_gate; j.ld = FFN; nN = 44; j.dst = (bf16_t*)(p.ws + WS_WGU); j.dstK = 1024; }
    else if (t < 2496) { job = 7; tt = t - 1792; j.src = p.w_up; j.ld = FFN; nN = 44; j.dst = (bf16_t*)(p.ws + WS_WGU); j.dstK = 1024; }
    else { job = 8; tt = t - 2496; j.src = p.w_down; j.ld = 1024; nN = 16; j.dst = (bf16_t*)(p.ws + WS_WD); j.dstK = FFN; }
    const int kt = tt / nN, ntile = tt % nN; j.n0 = ntile * 64; j.k0 = kt * 64;
    j.dr0 = j.n0;
    if (job == 4) j.dr0 = 256 + j.n0;
    else if (job == 6) j.dr0 = (j.n0 >> 7) * 256 + (j.n0 & 127);
    else if (job == 7) j.dr0 = (j.n0 >> 7) * 256 + 128 + (j.n0 & 127);
    j.gk = (job == 2) ? p.g_cross : ((job == 6 || job == 7) ? p.g_ffn : nullptr);
    return j;
}
constexpr int TILE_F = 64 * 65;
__device__ __forceinline__ void conv_tiles(const Params& p, unsigned char* shm, int t_lo, int t_hi, int w, int nw) {
    const int tid = opaque_tid();
    float* tiles = (float*)shm;
    for (int t0 = t_lo + 4 * w; t0 < t_hi; t0 += 4 * nw) {
#pragma unroll
        for (int q = 0; q < 4; ++q) {
            if (t0 + q < t_hi) { const TileJob j = decode_tile(p, t0 + q); float* tile = tiles + q * TILE_F;
#pragma unroll
                for (int i = 0; i < 8; ++i) { const int kl = (tid >> 6) + 8 * i, nl = tid & 63; const float gs = j.gk ? j.gk[j.k0 + kl] : 1.0f; tile[kl * 65 + nl] = j.src[(size_t)(j.k0 + kl) * j.ld + j.n0 + nl] * gs; } }
        }
        __syncthreads();
#pragma unroll
        for (int q = 0; q < 4; ++q) {
            if (t0 + q < t_hi) { const TileJob j = decode_tile(p, t0 + q); const float* tile = tiles + q * TILE_F;
                const int nl = tid >> 3, kc = tid & 7; float v[8];
#pragma unroll
                for (int jj = 0; jj < 8; ++jj) v[jj] = tile[(kc * 8 + jj) * 65 + nl];
                u32x4 o; o[0] = pk_bf16(v[0], v[1]); o[1] = pk_bf16(v[2], v[3]); o[2] = pk_bf16(v[4], v[5]); o[3] = pk_bf16(v[6], v[7]);
                *(u32x4*)(j.dst + (size_t)(j.dr0 + nl) * j.dstK + j.k0 + kc * 8) = o; }
        }
        __syncthreads();
    }
}
constexpr int T_EARLY = 704, T_MID = 1024, T_ALL = 3200;

__device__ __forceinline__ void phase0(const Params& p, unsigned char* shm, bool all_tiles) {
    const int tid = opaque_tid(), lane = tid & 63, wid = tid >> 6;
    float* wgT = (float*)(shm + 4 * TILE_F * 4);
    for (int idx = tid; idx < 8192; idx += NTHREADS) { const int k = idx >> 3, j = idx & 7; wgT[j * 1024 + k] = p.w_in[(size_t)k * INW + ZW + j]; }
    __syncthreads();
    {
        bf16_t* XN = (bf16_t*)(p.ws + WS_XN); bf16_t* MN = (bf16_t*)(p.ws + WS_MN); float* GT = (float*)(p.ws + WS_GATES);
        for (int rp = blockIdx.x * 8 + wid; rp < (M + 1024) / 2; rp += gridDim.x * 8) {
            const int row0 = 2 * rp;
            const bool ismem = row0 >= M;
            const float* gg = ismem ? p.g_mem : p.g_mix;
            f32x4 v[2][4]; float ss[2];
#pragma unroll
            for (int q = 0; q < 2; ++q) { const int row = row0 + q; const float* src = ismem ? p.mem_prompt + (size_t)(row - M) * D : xrow(p, row);
#pragma unroll
                for (int i = 0; i < 4; ++i) v[q][i] = __builtin_nontemporal_load((const f32x4*)(src + 4 * (lane + 64 * i))); }
            f32x4 gv[4];
#pragma unroll
            for (int i = 0; i < 4; ++i) gv[i] = *(const f32x4*)(gg + 4 * (lane + 64 * i));
#pragma unroll
            for (int q = 0; q < 2; ++q) { float s = 0.f;
#pragma unroll
                for (int i = 0; i < 4; ++i) s += v[q][i][0] * v[q][i][0] + v[q][i][1] * v[q][i][1] + v[q][i][2] * v[q][i][2] + v[q][i][3] * v[q][i][3];
                ss[q] = wave_sum(s); }
#pragma unroll
            for (int q = 0; q < 2; ++q) {
                const int row = row0 + q;
                const float rstd = rsqrtf(ss[q] * (1.0f / D) + 1e-6f);
                bf16_t* dst = ismem ? MN + (size_t)(row - M) * D : XN + (size_t)row * D;
#pragma unroll
                for (int i = 0; i < 4; ++i) { v[q][i] = v[q][i] * rstd * gv[i];
                    u32x2 o; o[0] = pk_bf16(v[q][i][0], v[q][i][1]); o[1] = pk_bf16(v[q][i][2], v[q][i][3]); *(u32x2*)(dst + 4 * (lane + 64 * i)) = o; }
            }
            if (!ismem) {
#pragma unroll
                for (int q = 0; q < 2; ++q) {
                    float a8[8];
#pragma unroll
                    for (int j = 0; j < 8; ++j) { float a = 0.f;
#pragma unroll
                        for (int i = 0; i < 4; ++i) { const f32x4 w = *(const f32x4*)(wgT + j * 1024 + 4 * (lane + 64 * i)); a += v[q][i][0] * w[0] + v[q][i][1] * w[1] + v[q][i][2] * w[2] + v[q][i][3] * w[3]; }
                        a8[j] = a; }
                    const bool h5 = lane & 32, h4 = lane & 16, h3 = lane & 8;
                    float b4[4], c2[2];
#pragma unroll
                    for (int j = 0; j < 4; ++j) { const float snd = h5 ? a8[j] : a8[j + 4]; const float rcv = __shfl_xor(snd, 32); b4[j] = (h5 ? a8[j + 4] : a8[j]) + rcv; }
#pragma unroll
                    for (int j = 0; j < 2; ++j) { const float snd = h4 ? b4[j] : b4[j + 2]; const float rcv = __shfl_xor(snd, 16); c2[j] = (h4 ? b4[j + 2] : b4[j]) + rcv; }
                    float z;
                    { const float snd = h3 ? c2[0] : c2[1]; const float rcv = __shfl_xor(snd, 8); z = (h3 ? c2[1] : c2[0]) + rcv; }
                    z += __shfl_xor(z, 4); z += __shfl_xor(z, 2); z += __shfl_xor(z, 1);
                    if ((lane & 7) == 0) {
                        const int gidx = lane >> 3;
                        float o;
                        if (gidx < 4) o = z + p.b_ig[gidx];
                        else { const float xx = z + p.b_fg[gidx - 4]; o = fminf(xx, 0.f) - log1pf(__expf(-fabsf(xx))); }
                        GT[(size_t)(row0 + q) * 8 + gidx] = o;
                    }
                }
            }
        }
    }
    __syncthreads();
    conv_tiles(p, shm, 0, all_tiles ? T_ALL : T_EARLY, blockIdx.x, gridDim.x);
}

constexpr int KSTR = 72;
template <class MaskF, class FullF>
__device__ __forceinline__ void attn_tiles(const bf16_t* Ks, const bf16_t* Vt, int vstr, const bf16x8 (&Qf)[4], int t0, int t1, float scale_log2, const MaskF& mask, const FullF& full,
                                           f32x16& O0, f32x16& O1, float& m_run, float& l_run) {
    const int lane = threadIdx.x & 63, r = lane & 31, h = lane >> 5;
    for (int t = t0; t < t1; ++t) {
        f32x16 S;
#pragma unroll
        for (int i = 0; i < 16; ++i) S[i] = 0.f;
#pragma unroll
        for (int s = 0; s < 4; ++s) {
            const bf16x8 a = *(const bf16x8*)(Ks + (t * 32 + r) * KSTR + 16 * s + 8 * h);
            __builtin_amdgcn_s_setprio(1);
            S = __builtin_amdgcn_mfma_f32_32x32x16_bf16(a, Qf[s], S, 0, 0, 0);
            __builtin_amdgcn_s_setprio(0);
        }
        float mx = -INFINITY;
        if (full(t)) {
#pragma unroll
            for (int i = 0; i < 16; ++i) mx = fmaxf(mx, S[i]);
        } else {
#pragma unroll
            for (int i = 0; i < 16; ++i) { const int kk = t * 32 + (i & 3) + 8 * (i >> 2) + 4 * h; const float v = mask(kk) ? S[i] : -INFINITY; S[i] = v; mx = fmaxf(mx, v); }
        }
        mx = fmaxf(mx, __shfl_xor(mx, 32));
        const float mn = fmaxf(m_run, mx * scale_log2);
        if (__builtin_amdgcn_ballot_w64(mn != m_run) != 0ull) {
            const float alpha = __builtin_amdgcn_exp2f(m_run - mn);
            l_run *= alpha; m_run = mn;
#pragma unroll
            for (int i = 0; i < 16; ++i) { O0[i] *= alpha; O1[i] *= alpha; }
        }
        float rs = 0.f;
#pragma unroll
        for (int i = 0; i < 16; ++i) { const float pp = __builtin_amdgcn_exp2f(__builtin_fmaf(S[i], scale_log2, -mn)); S[i] = pp; rs += pp; }
        rs += __shfl_xor(rs, 32);
        l_run += rs;
#pragma unroll
        for (int s2 = 0; s2 < 2; ++s2) {
            u32x4 pbu; pbu[0] = pk_bf16(S[8 * s2 + 0], S[8 * s2 + 1]); pbu[1] = pk_bf16(S[8 * s2 + 2], S[8 * s2 + 3]); pbu[2] = pk_bf16(S[8 * s2 + 4], S[8 * s2 + 5]); pbu[3] = pk_bf16(S[8 * s2 + 6], S[8 * s2 + 7]);
            const bf16x8 pb = __builtin_bit_cast(bf16x8, pbu);
            {
                const bf16_t* vp = Vt + (size_t)r * vstr + t * 32 + 16 * s2 + 4 * h;
                u32x4 au; const u32x2 lo = *(const u32x2*)vp, hi = *(const u32x2*)(vp + 8); au[0] = lo[0]; au[1] = lo[1]; au[2] = hi[0]; au[3] = hi[1];
                O0 = __builtin_amdgcn_mfma_f32_32x32x16_bf16(__builtin_bit_cast(bf16x8, au), pb, O0, 0, 0, 0);
            }
            {
                const bf16_t* vp = Vt + (size_t)(32 + r) * vstr + t * 32 + 16 * s2 + 4 * h;
                u32x4 au; const u32x2 lo = *(const u32x2*)vp, hi = *(const u32x2*)(vp + 8); au[0] = lo[0]; au[1] = lo[1]; au[2] = hi[0]; au[3] = hi[1];
                O1 = __builtin_amdgcn_mfma_f32_32x32x16_bf16(__builtin_bit_cast(bf16x8, au), pb, O1, 0, 0, 0);
            }
        }
    }
}
__device__ __forceinline__ void attn_store(bf16_t* dst, const f32x16& O0, const f32x16& O1, float l_run, int h) {
    const float inv = 1.0f / l_run;
#pragma unroll
    for (int g = 0; g < 4; ++g) {
        u32x2 o; o[0] = pk_bf16(O0[4 * g] * inv, O0[4 * g + 1] * inv); o[1] = pk_bf16(O0[4 * g + 2] * inv, O0[4 * g + 3] * inv);
        *(u32x2*)(dst + 8 * g + 4 * h) = o;
        u32x2 o1; o1[0] = pk_bf16(O1[4 * g] * inv, O1[4 * g + 1] * inv); o1[1] = pk_bf16(O1[4 * g + 2] * inv, O1[4 * g + 3] * inv);
        *(u32x2*)(dst + 32 + 8 * g + 4 * h) = o1;
    }
}
constexpr float SCALE_LOG2 = 0.125f * 1.4426950408889634f;
constexpr float LOG2E = 1.4426950408889634f;

__device__ __forceinline__ void swa_prompt_unit(const Params& p, unsigned char* shm, int unit) {
    const int tid = opaque_tid(), lane = tid & 63, wid = tid >> 6, r = lane & 31, h = lane >> 5;
    const int n = unit & 31, kvh = (unit >> 5) & 1, b = unit >> 6;
    const int start = n * 128;
    const bf16_t* Z = (const bf16_t*)(p.ws + WS_Z);
    bf16_t* CAT = (bf16_t*)(p.ws + WS_CAT);
    bf16_t* Ks = (bf16_t*)shm;
    bf16_t* Vt = (bf16_t*)(shm + 256 * KSTR * 2);
    constexpr int VSTR = 264;
#pragma unroll
    for (int i = 0; i < 4; ++i) {
        const int idx = tid + 512 * i, key = idx >> 3, ch = idx & 7;
        const int tok = start - 128 + key;
        u32x4 kq = {0u, 0u, 0u, 0u}, vq = {0u, 0u, 0u, 0u};
        if (tok >= 0) { const bf16_t* zr = Z + (size_t)(b * SEQ + tok) * ZW + kvh * 64 + ch * 8; kq = *(const u32x4*)(zr + ZK); vq = *(const u32x4*)(zr + ZV); }
        *(u32x4*)(Ks + key * KSTR + ch * 8) = kq;
#pragma unroll
        for (int j = 0; j < 4; ++j) { Vt[(ch * 8 + 2 * j) * VSTR + key] = (bf16_t)(vq[j] & 0xffffu); Vt[(ch * 8 + 2 * j + 1) * VSTR + key] = (bf16_t)(vq[j] >> 16); }
    }
    __syncthreads();
    const int g = wid >> 1, half = wid & 1, head = kvh * 4 + g;
    const float sink = p.sinks[head] * LOG2E;
    for (int qb = 0; qb < 2; ++qb) {
        const int i0 = half * 64 + qb * 32, qi = i0 + r;
        const int row = b * SEQ + start + qi;
        bf16x8 Qf[4];
#pragma unroll
        for (int s = 0; s < 4; ++s) Qf[s] = *(const bf16x8*)(Z + (size_t)row * ZW + ZQ + head * 64 + 16 * s + 8 * h);
        f32x16 O0, O1;
#pragma unroll
        for (int i = 0; i < 16; ++i) { O0[i] = 0.f; O1[i] = 0.f; }
        float m_run = sink, l_run = 1.0f;
        const int kmin = (start == 0) ? 128 : 0;
        auto mask = [=](int kk) { return kk >= qi && kk <= qi + 128 && kk >= kmin; };
        const int tb = i0 >> 5;
        auto full = [=](int t) { return t > tb && t < tb + 4 && 32 * t >= kmin; };
        attn_tiles(Ks, Vt, VSTR, Qf, tb, tb + 5, SCALE_LOG2, mask, full, O0, O1, m_run, l_run);
        attn_store(CAT + (size_t)row * D + head * 64, O0, O1, l_run, h);
    }
    __syncthreads();
}

__device__ __forceinline__ void swa_sample_unit(const Params& p, unsigned char* shm, int b) {
    const int tid = opaque_tid(), lane = tid & 63, wid = tid >> 6, r = lane & 31, h = lane >> 5;
    const bf16_t* Z = (const bf16_t*)(p.ws + WS_Z);
    bf16_t* CAT = (bf16_t*)(p.ws + WS_CAT);
    constexpr int VSTR = 168, KIMG = 160 * KSTR, VIMG = 64 * VSTR;
    bf16_t* Ks = (bf16_t*)shm;
    bf16_t* Vt = (bf16_t*)(shm + 2 * KIMG * 2);
    float* outk = p.out + O_SKS + (size_t)b * 16384; float* outv = p.out + O_SVS + (size_t)b * 16384;
    const float* ck = p.cache_swa_k + (size_t)b * 16384; const float* cv = p.cache_swa_v + (size_t)b * 16384;
    for (int idx = tid; idx < 2 * 24 * KSTR; idx += NTHREADS) { const int kv = idx / (24 * KSTR), rem = idx % (24 * KSTR); Ks[kv * KIMG + 136 * KSTR + rem] = 0; }
    for (int idx = tid; idx < 2 * 64 * 24; idx += NTHREADS) { const int kv = idx / (64 * 24), rem = idx % (64 * 24), d = rem / 24, kk = rem % 24; Vt[kv * VIMG + d * VSTR + 136 + kk] = 0; }
#pragma unroll
    for (int i = 0; i < 8; ++i) {
        const int idx = tid + 512 * i, j = idx >> 5, c4 = idx & 31, kvh = c4 >> 4, d = (c4 & 15) * 4;
        const f32x4 kq = __builtin_nontemporal_load((const f32x4*)(ck + j * 128 + c4 * 4)), vq = __builtin_nontemporal_load((const f32x4*)(cv + j * 128 + c4 * 4));
        u32x2 o; o[0] = pk_bf16(kq[0], kq[1]); o[1] = pk_bf16(kq[2], kq[3]);
        *(u32x2*)(Ks + kvh * KIMG + j * KSTR + d) = o;
        const unsigned v01 = pk_bf16(vq[0], vq[1]), v23 = pk_bf16(vq[2], vq[3]);
        bf16_t* vb = Vt + kvh * VIMG + d * VSTR + j;
        vb[0] = (bf16_t)(v01 & 0xffffu); vb[VSTR] = (bf16_t)(v01 >> 16); vb[2 * VSTR] = (bf16_t)(v23 & 0xffffu); vb[3 * VSTR] = (bf16_t)(v23 >> 16);
        if (j >= 8) { *(f32x4*)(outk + (j - 8) * 128 + c4 * 4) = kq; *(f32x4*)(outv + (j - 8) * 128 + c4 * 4) = vq; }
    }
    {
        const int e = tid * 2, t = e >> 7, col = e & 127, kvh = col >> 6, d = col & 63;
        const bf16_t* zr = Z + (size_t)(MP + b * 8 + t) * ZW;
        const unsigned kq = *(const unsigned*)(zr + ZK + col), vq = *(const unsigned*)(zr + ZV + col);
        *(unsigned*)(Ks + kvh * KIMG + (128 + t) * KSTR + d) = kq;
        Vt[kvh * VIMG + d * VSTR + 128 + t] = (bf16_t)(vq & 0xffffu); Vt[kvh * VIMG + (d + 1) * VSTR + 128 + t] = (bf16_t)(vq >> 16);
        outk[(120 + t) * 128 + col] = bf_lo(kq); outk[(120 + t) * 128 + col + 1] = bf_hi(kq);
        outv[(120 + t) * 128 + col] = bf_lo(vq); outv[(120 + t) * 128 + col + 1] = bf_hi(vq);
    }
    __syncthreads();
    if (wid < 2) {
        const int kvh = wid, g = r >> 3, t = r & 7, head = kvh * 4 + g;
        const int row = MP + b * 8 + t;
        bf16x8 Qf[4];
#pragma unroll
        for (int s = 0; s < 4; ++s) Qf[s] = *(const bf16x8*)(Z + (size_t)row * ZW + ZQ + head * 64 + 16 * s + 8 * h);
        f32x16 O0, O1;
#pragma unroll
        for (int i = 0; i < 16; ++i) { O0[i] = 0.f; O1[i] = 0.f; }
        float m_run = p.sinks[head] * LOG2E, l_run = 1.0f;
        auto mask = [=](int kk) { return kk >= t && kk <= t + 128; };
        auto full = [=](int tt) { return tt >= 1 && tt <= 3; };
        attn_tiles(Ks + kvh * KIMG, Vt + kvh * VIMG, VSTR, Qf, 0, 5, SCALE_LOG2, mask, full, O0, O1, m_run, l_run);
        attn_store(CAT + (size_t)row * D + head * 64, O0, O1, l_run, h);
    }
    __syncthreads();
}

__device__ __forceinline__ void cross_prompt_unit(const Params& p, unsigned char* shm, int unit) {
    const int tid = opaque_tid(), lane = tid & 63, wid = tid >> 6, r = lane & 31, h = lane >> 5;
    const int qt = unit & 15, head = (unit >> 4) & 3, b = unit >> 6;
    const bf16_t* MKV = (const bf16_t*)(p.ws + WS_MEMKV);
    const bf16_t* Q2 = (const bf16_t*)(p.ws + WS_Q2);
    bf16_t* O2 = (bf16_t*)(p.ws + WS_O2);
    bf16_t* Ks = (bf16_t*)shm; bf16_t* Vt = (bf16_t*)(shm + 256 * KSTR * 2);
    constexpr int VSTR = 264;
#pragma unroll
    for (int i = 0; i < 4; ++i) {
        const int idx = tid + 512 * i, key = idx >> 3, ch = idx & 7;
        const bf16_t* mr = MKV + (size_t)(b * 256 + key) * 512 + head * 64 + ch * 8;
        const u32x4 kq = *(const u32x4*)mr, vq = *(const u32x4*)(mr + 256);
        *(u32x4*)(Ks + key * KSTR + ch * 8) = kq;
#pragma unroll
        for (int j = 0; j < 4; ++j) { Vt[(ch * 8 + 2 * j) * VSTR + key] = (bf16_t)(vq[j] & 0xffffu); Vt[(ch * 8 + 2 * j + 1) * VSTR + key] = (bf16_t)(vq[j] >> 16); }
    }
    __syncthreads();
    const int row = b * SEQ + qt * 256 + wid * 32 + r;
    bf16x8 Qf[4];
#pragma unroll
    for (int s = 0; s < 4; ++s) Qf[s] = *(const bf16x8*)(Q2 + (size_t)row * 256 + head * 64 + 16 * s + 8 * h);
    f32x16 O0, O1;
#pragma unroll
    for (int i = 0; i < 16; ++i) { O0[i] = 0.f; O1[i] = 0.f; }
    float m_run = -1e30f, l_run = 0.f;
    auto mask = [=](int) { return true; };
    attn_tiles(Ks, Vt, VSTR, Qf, 0, 8, SCALE_LOG2, mask, mask, O0, O1, m_run, l_run);
    attn_store(O2 + (size_t)row * 256 + head * 64, O0, O1, l_run, h);
    __syncthreads();
}
__device__ __forceinline__ void cross_sample_unit(const Params& p, unsigned char* shm, int unit) {
    const int tid = opaque_tid(), lane = tid & 63, wid = tid >> 6, r = lane & 31, h = lane >> 5;
    const int head = unit & 3, b = unit >> 2;
    const bf16_t* Q2 = (const bf16_t*)(p.ws + WS_Q2);
    bf16_t* O2 = (bf16_t*)(p.ws + WS_O2);
    bf16_t* Ks = (bf16_t*)shm; bf16_t* Vt = (bf16_t*)(shm + 256 * KSTR * 2);
    constexpr int VSTR = 264;
#pragma unroll
    for (int i = 0; i < 8; ++i) {
        const int idx = tid + 512 * i, key = idx >> 4, c4 = idx & 15, d = c4 * 4;
        const size_t off = ((size_t)(b * 256 + key) * 4 + head) * 64 + d;
        const f32x4 kq = __builtin_nontemporal_load((const f32x4*)(p.cache_mem_k + off)), vq = __builtin_nontemporal_load((const f32x4*)(p.cache_mem_v + off));
        u32x2 o; o[0] = pk_bf16(kq[0], kq[1]); o[1] = pk_bf16(kq[2], kq[3]);
        *(u32x2*)(Ks + key * KSTR + d) = o;
        const unsigned v01 = pk_bf16(vq[0], vq[1]), v23 = pk_bf16(vq[2], vq[3]);
        bf16_t* vb = Vt + d * VSTR + key;
        vb[0] = (bf16_t)(v01 & 0xffffu); vb[VSTR] = (bf16_t)(v01 >> 16); vb[2 * VSTR] = (bf16_t)(v23 & 0xffffu); vb[3 * VSTR] = (bf16_t)(v23 >> 16);
    }
    __syncthreads();
    if (wid == 0) {
        const int t = r & 7, row = MP + b * 8 + t;
        bf16x8 Qf[4];
#pragma unroll
        for (int s = 0; s < 4; ++s) Qf[s] = *(const bf16x8*)(Q2 + (size_t)row * 256 + head * 64 + 16 * s + 8 * h);
        f32x16 O0, O1;
#pragma unroll
        for (int i = 0; i < 16; ++i) { O0[i] = 0.f; O1[i] = 0.f; }
        float m_run = -1e30f, l_run = 0.f;
        auto mask = [=](int) { return true; };
        attn_tiles(Ks, Vt, VSTR, Qf, 0, 8, SCALE_LOG2, mask, mask, O0, O1, m_run, l_run);
        if (r < 8) attn_store(O2 + (size_t)row * 256 + head * 64, O0, O1, l_run, h);
    }
    __syncthreads();
}

__device__ __forceinline__ void unpack8(const u32x4 q, float* v) {
#pragma unroll
    for (int j = 0; j < 4; ++j) { v[2 * j] = bf_lo(q[j]); v[2 * j + 1] = bf_hi(q[j]); }
}
__device__ __forceinline__ void mlstm_scan(const Params& p) {
    const float* SC = (const float*)(p.ws + WS_SCAL); float* MPV = (float*)(p.ws + WS_SCAL) + 2048;
    const bf16_t* UT = (const bf16_t*)(p.ws + WS_UT); const float* NT = (const float*)(p.ws + WS_NT);
    bf16_t* CPREV = (bf16_t*)(p.ws + WS_CPREV); float* NPREV = (float*)(p.ws + WS_NPREV);
    const int tid = opaque_tid();
    if (tid >= NTHREADS / 2) return;
    for (int base = blockIdx.x * NTHREADS; base < 16 * 8192; base += gridDim.x * NTHREADS) {
        const int bh = base >> 13, e0 = (base & 8191) + 2 * tid;
        const bool doN = e0 < 64;
        float m = 0.f, C0 = 0.f, C1 = 0.f, n0 = 0.f, n1 = 0.f;
#pragma unroll 1
        for (int hf = 0; hf < 2; ++hf) {
            const int u0 = bh * 64 + hf * 32;
            unsigned uu[32]; float na[32], nb[32];
#pragma unroll
            for (int j = 0; j < 32; ++j) uu[j] = *(const unsigned*)(UT + (size_t)(u0 + j) * 8192 + e0);
            if (doN) {
#pragma unroll
                for (int j = 0; j < 32; ++j) { na[j] = NT[(u0 + j) * 64 + e0]; nb[j] = NT[(u0 + j) * 64 + e0 + 1]; }
            } else {
#pragma unroll
                for (int j = 0; j < 32; ++j) { na[j] = 0.f; nb[j] = 0.f; }
            }
#pragma unroll
            for (int j = 0; j < 32; ++j) {
                const int unit = u0 + j;
                const float A = SC[unit], bL = SC[1024 + unit];
                *(unsigned*)(CPREV + (size_t)unit * 8192 + e0) = pk_bf16(C0, C1);
                if (doN) { NPREV[unit * 64 + e0] = n0; NPREV[unit * 64 + e0 + 1] = n1; }
                if (e0 == 0) MPV[unit] = m;
                const float mn = bL + fmaxf(A, m);
                const float wc = __expf(bL + m - mn), g = __expf(A + bL - mn);
                C0 = wc * C0 + g * bf_lo(uu[j]); C1 = wc * C1 + g * bf_hi(uu[j]);
                n0 = wc * n0 + g * na[j]; n1 = wc * n1 + g * nb[j];
                m = mn;
            }
        }
        p.out[O_CP + (size_t)bh * 8192 + e0] = C0; p.out[O_CP + (size_t)bh * 8192 + e0 + 1] = C1;
        if (doN) { p.out[O_NP + bh * 64 + e0] = n0; p.out[O_NP + bh * 64 + e0 + 1] = n1; }
        if (e0 == 0) p.out[O_MP + bh] = m;
    }
}

constexpr int MVS = 72;
constexpr int ML_SLOT = 128 * MVS * 2 + 64 * MVS * 2 + 256;
__device__ __forceinline__ void mlstm_local_group(const Params& p, unsigned char* shm, int grp) {
    const int tid = opaque_tid(), lane = tid & 63, wid = tid >> 6, slot = wid >> 1, wq = wid & 1, r = lane & 31, hl = lane >> 5;
    const int unit = grp * 4 + slot, bh = unit >> 6, c = unit & 63, b = bh >> 2, hh = bh & 3;
    const int row0 = b * SEQ + c * 64;
    const bf16_t* Z = (const bf16_t*)(p.ws + WS_Z);
    const float* GT = (const float*)(p.ws + WS_GATES);
    float* SC = (float*)(p.ws + WS_SCAL);
    bf16_t* UT = (bf16_t*)(p.ws + WS_UT); float* NT = (float*)(p.ws + WS_NT);
    bf16_t* Vt = (bf16_t*)(shm + slot * ML_SLOT);
    bf16_t* Kt = Vt + 128 * MVS;
    float* sW = (float*)(Kt + 64 * MVS);
    const float lf = GT[(size_t)(row0 + lane) * 8 + 4 + hh], ig = GT[(size_t)(row0 + lane) * 8 + hh];
    const float bt = wave_scan_add(lf, lane);
    const float a = ig - bt;
    const float A = wave_max(a);
    const float wt = __expf(a - A);
    if (wq == 0) { sW[lane] = wt; if (lane == 63) SC[1024 + unit] = bt; if (lane == 0) SC[unit] = A; }
    const bf16_t* zr = Z + (size_t)(row0 + lane) * ZW;
#pragma unroll
    for (int i = 0; i < 8; ++i) { const int ch = wq + 2 * i; float v[8];
        unpack8(*(const u32x4*)(zr + ZMV + hh * 128 + ch * 8), v);
#pragma unroll
        for (int j = 0; j < 8; j += 2) { const unsigned pk = pk_bf16(v[j] * wt, v[j + 1] * wt); Vt[(ch * 8 + j) * MVS + lane] = (bf16_t)(pk & 0xffffu); Vt[(ch * 8 + j + 1) * MVS + lane] = (bf16_t)(pk >> 16); } }
#pragma unroll
    for (int i = 0; i < 4; ++i) { const int ch = wq + 2 * i; float v[8];
        unpack8(*(const u32x4*)(zr + ZMK + hh * 64 + ch * 8), v);
#pragma unroll
        for (int j = 0; j < 8; j += 2) { const unsigned pk = pk_bf16(v[j] * 0.125f, v[j + 1] * 0.125f); Kt[(ch * 8 + j) * MVS + lane] = (bf16_t)(pk & 0xffffu); Kt[(ch * 8 + j + 1) * MVS + lane] = (bf16_t)(pk >> 16); } }
    __syncthreads();
    f32x16 acc[2][2];
#pragma unroll
    for (int e = 0; e < 2; ++e)
#pragma unroll
        for (int d = 0; d < 2; ++d)
#pragma unroll
            for (int i = 0; i < 16; ++i) acc[e][d][i] = 0.f;
#pragma unroll
    for (int ks = 0; ks < 4; ++ks) {
        bf16x8 Af[2], Bf[2];
#pragma unroll
        for (int e = 0; e < 2; ++e) Af[e] = *(const bf16x8*)(Vt + (32 * (2 * wq + e) + r) * MVS + 16 * ks + 8 * hl);
#pragma unroll
        for (int d = 0; d < 2; ++d) Bf[d] = *(const bf16x8*)(Kt + (32 * d + r) * MVS + 16 * ks + 8 * hl);
#pragma unroll
        for (int e = 0; e < 2; ++e)
#pragma unroll
            for (int d = 0; d < 2; ++d) acc[e][d] = __builtin_amdgcn_mfma_f32_32x32x16_bf16(Af[e], Bf[d], acc[e][d], 0, 0, 0);
    }
#pragma unroll
    for (int e = 0; e < 2; ++e)
#pragma unroll
        for (int d = 0; d < 2; ++d)
#pragma unroll
            for (int i = 0; i < 16; ++i) { const int ee = 32 * (2 * wq + e) + (i & 3) + 8 * (i >> 2) + 4 * hl;
                UT[(size_t)unit * 8192 + ee * 64 + 32 * d + r] = (bf16_t)(pk_bf16(acc[e][d][i], acc[e][d][i]) & 0xffffu); }
    if (wq == 1) { float nn = 0.f;
#pragma unroll 8
        for (int s = 0; s < 64; ++s) nn += sW[s] * bf2f(Kt[lane * MVS + s]);
        NT[(size_t)unit * 64 + lane] = nn; }
    __syncthreads();
}
__device__ __forceinline__ void mlstm_out_group(const Params& p, unsigned char* shm, int grp) {
    const int tid = opaque_tid(), lane = tid & 63, wid = tid >> 6, slot = wid >> 1, qb = wid & 1, r = lane & 31, hl = lane >> 5;
    const int unit = grp * 4 + slot, bh = unit >> 6, c = unit & 63, b = bh >> 2, hh = bh & 3;
    const int row0 = b * SEQ + c * 64;
    const bf16_t* Z = (const bf16_t*)(p.ws + WS_Z);
    const float* GT = (const float*)(p.ws + WS_GATES);
    const float* MPV = (const float*)(p.ws + WS_SCAL) + 2048;
    const bf16_t* CPREV = (const bf16_t*)(p.ws + WS_CPREV) + (size_t)unit * 8192; const float* NPREV = (const float*)(p.ws + WS_NPREV) + unit * 64;
    bf16_t* CAT = (bf16_t*)(p.ws + WS_CAT);
    bf16_t* Vt = (bf16_t*)(shm + slot * ML_SLOT);
    float* sA = (float*)(Vt + 128 * MVS + 64 * MVS);
    const float lf = GT[(size_t)(row0 + lane) * 8 + 4 + hh], ig = GT[(size_t)(row0 + lane) * 8 + hh];
    const float bt = wave_scan_add(lf, lane);
    const float a = ig - bt;
    const float cm = wave_scan_max(a, lane);
    const float mprev = MPV[unit];
    const float mt = bt + fmaxf(cm, mprev);
    const float wi = __expf(bt + mprev - mt);
    if (qb == 0) sA[lane] = a;
    u32x4 ogr[8];
    { const int tp = qb * 64 + lane;
#pragma unroll
      for (int i = 0; i < 8; ++i) { const int idx = tp + 128 * i, orow = idx >> 4, oc = idx & 15; ogr[i] = *(const u32x4*)(Z + (size_t)(row0 + orow) * ZW + ZOG + hh * 128 + oc * 8); } }
    const int l = 32 * qb + r;
    const float bt_l = __shfl(bt, l), mt_l = __shfl(mt, l), wi_l = __shfl(wi, l);
    { const bf16_t* zr = Z + (size_t)(row0 + lane) * ZW + ZMV + hh * 128;
#pragma unroll
      for (int i = 0; i < 8; ++i) { const int ch = qb + 2 * i; const u32x4 q = *(const u32x4*)(zr + ch * 8);
#pragma unroll
          for (int j = 0; j < 4; ++j) { Vt[(ch * 8 + 2 * j) * MVS + lane] = (bf16_t)(q[j] & 0xffffu); Vt[(ch * 8 + 2 * j + 1) * MVS + lane] = (bf16_t)(q[j] >> 16); } } }
    bf16x8 Qf[4]; float qn = 0.f;
#pragma unroll
    for (int ks = 0; ks < 4; ++ks) {
        const u32x4 qq = *(const u32x4*)(Z + (size_t)(row0 + l) * ZW + ZMQ + hh * 64 + 16 * ks + 8 * hl);
        Qf[ks] = __builtin_bit_cast(bf16x8, qq);
        float qv[8]; unpack8(qq, qv);
        const f32x4 n0 = *(const f32x4*)(NPREV + 16 * ks + 8 * hl), n1 = *(const f32x4*)(NPREV + 16 * ks + 8 * hl + 4);
        qn += qv[0] * n0[0] + qv[1] * n0[1] + qv[2] * n0[2] + qv[3] * n0[3] + qv[4] * n1[0] + qv[5] * n1[1] + qv[6] * n1[2] + qv[7] * n1[3];
    }
    qn += __shfl_xor(qn, 32);
    f32x16 O[4];
#pragma unroll
    for (int eb = 0; eb < 4; ++eb) {
#pragma unroll
        for (int i = 0; i < 16; ++i) O[eb][i] = 0.f;
#pragma unroll
        for (int ks = 0; ks < 4; ++ks) {
            const bf16x8 cf = *(const bf16x8*)(CPREV + (32 * eb + r) * 64 + 16 * ks + 8 * hl);
            O[eb] = __builtin_amdgcn_mfma_f32_32x32x16_bf16(cf, Qf[ks], O[eb], 0, 0, 0);
        }
#pragma unroll
        for (int i = 0; i < 16; ++i) O[eb][i] *= wi_l;
    }
    bf16x8 Kf[2][4];
#pragma unroll
    for (int t = 0; t < 2; ++t)
#pragma unroll
        for (int ks = 0; ks < 4; ++ks) Kf[t][ks] = *(const bf16x8*)(Z + (size_t)(row0 + 32 * t + r) * ZW + ZMK + hh * 64 + 16 * ks + 8 * hl);
    __syncthreads();
    float rs = 0.f;
    const float ebase = bt_l - mt_l;
#pragma unroll
    for (int t = 0; t < 2; ++t) {
        if (t > qb) break;
        f32x16 S;
#pragma unroll
        for (int i = 0; i < 16; ++i) S[i] = 0.f;
#pragma unroll
        for (int ks = 0; ks < 4; ++ks) S = __builtin_amdgcn_mfma_f32_32x32x16_bf16(Kf[t][ks], Qf[ks], S, 0, 0, 0);
#pragma unroll
        for (int i = 0; i < 16; ++i) { const int s = 32 * t + (i & 3) + 8 * (i >> 2) + 4 * hl;
            const float w = (s <= l) ? S[i] * 0.125f * __expf(sA[s] + ebase) : 0.f; S[i] = w; rs += w; }
#pragma unroll
        for (int s2 = 0; s2 < 2; ++s2) {
            u32x4 pbu; pbu[0] = pk_bf16(S[8 * s2 + 0], S[8 * s2 + 1]); pbu[1] = pk_bf16(S[8 * s2 + 2], S[8 * s2 + 3]); pbu[2] = pk_bf16(S[8 * s2 + 4], S[8 * s2 + 5]); pbu[3] = pk_bf16(S[8 * s2 + 6], S[8 * s2 + 7]);
            const bf16x8 pb = __builtin_bit_cast(bf16x8, pbu);
#pragma unroll
            for (int eb = 0; eb < 4; ++eb) {
                const bf16_t* vp = Vt + (32 * eb + r) * MVS + t * 32 + 16 * s2 + 4 * hl;
                u32x4 au; const u32x2 lo = *(const u32x2*)vp, hi = *(const u32x2*)(vp + 8); au[0] = lo[0]; au[1] = lo[1]; au[2] = hi[0]; au[3] = hi[1];
                O[eb] = __builtin_amdgcn_mfma_f32_32x32x16_bf16(__builtin_bit_cast(bf16x8, au), pb, O[eb], 0, 0, 0);
            }
        }
    }
    rs += __shfl_xor(rs, 32);
    const float den = rs + wi_l * qn;
    const float inv = 1.0f / fmaxf(fabsf(den), __expf(-mt_l));
    float ss = 0.f;
#pragma unroll
    for (int eb = 0; eb < 4; ++eb)
#pragma unroll
        for (int i = 0; i < 16; ++i) { const float hv = O[eb][i] * inv; O[eb][i] = hv; ss += hv * hv; }
    ss += __shfl_xor(ss, 32);
    const float rstd = rsqrtf(ss * (1.0f / 128.0f) + 1e-6f);
    __syncthreads();
    bf16_t* T = Vt;
    constexpr int TS = 136;
#pragma unroll
    for (int eb = 0; eb < 4; ++eb)
#pragma unroll
        for (int g4 = 0; g4 < 4; ++g4) {
            const int e0 = 32 * eb + 8 * g4 + 4 * hl;
            const f32x4 gh = *(const f32x4*)(p.g_head + hh * 128 + e0);
            u32x2 o; o[0] = pk_bf16(O[eb][4 * g4] * rstd * gh[0], O[eb][4 * g4 + 1] * rstd * gh[1]); o[1] = pk_bf16(O[eb][4 * g4 + 2] * rstd * gh[2], O[eb][4 * g4 + 3] * rstd * gh[3]);
            *(u32x2*)(T + l * TS + e0) = o;
        }
    __syncthreads();
    { const int tp = qb * 64 + lane;
#pragma unroll
      for (int i = 0; i < 8; ++i) { const int idx = tp + 128 * i, orow = idx >> 4, oc = idx & 15;
          const u32x4 pre = *(const u32x4*)(T + orow * TS + oc * 8); const u32x4 og = ogr[i];
          u32x4 o;
#pragma unroll
          for (int k = 0; k < 4; ++k) {
              const float v0 = bf_lo(pre[k]) * __builtin_amdgcn_rcpf(1.0f + __expf(-bf_lo(og[k]))), v1 = bf_hi(pre[k]) * __builtin_amdgcn_rcpf(1.0f + __expf(-bf_hi(og[k])));
              o[k] = pk_bf16(v0, v1); }
          *(u32x4*)(CAT + (size_t)(row0 + orow) * D + 512 + hh * 128 + oc * 8) = o; } }
    __syncthreads();
}

__device__ __forceinline__ void mlstm_sample_group(const Params& p, unsigned char* shm, int b) {
    const int tid = opaque_tid(), hh = tid >> 7, tp = tid & 127, lane = tid & 63, wv = (tid >> 6) & 1;
    const int unit = b * 4 + hh, row0 = MP + b * 8, e = tp;
    const bf16_t* Z = (const bf16_t*)(p.ws + WS_Z);
    const float* GT = (const float*)(p.ws + WS_GATES);
    bf16_t* CAT = (bf16_t*)(p.ws + WS_CAT);
    float* L = (float*)shm + hh * 3584;
    float* qs = L;
    float* ks = qs + 512;
    float* vs = ks + 512;
    float* Ss = vs + 1024;
    float* sm = Ss + 64;
    float* s_a = sm, *s_bt = sm + 8, *s_mt = sm + 16, *s_wi = sm + 24, *s_wk = sm + 32, *s_den = sm + 40, *s_misc = sm + 56;
    float* s_n = sm + 64;
    float* red = s_n + 64;
    f32x4 C4[16];
    { const float* Cin = p.st_C + (size_t)unit * 8192 + e * 64;
#pragma unroll
      for (int i = 0; i < 16; ++i) C4[i] = __builtin_nontemporal_load((const f32x4*)(Cin + 4 * i)); }
#pragma unroll
    for (int i = 0; i < 4; ++i) { const int idx = tp + 128 * i, t = idx >> 6, d = idx & 63; const bf16_t* zr = Z + (size_t)(row0 + t) * ZW;
        qs[idx] = bf2f(zr[ZMQ + hh * 64 + d]); ks[idx] = bf2f(zr[ZMK + hh * 64 + d]) * 0.125f; }
#pragma unroll
    for (int i = 0; i < 8; ++i) { const int idx = tp + 128 * i, t = idx >> 7, ee = idx & 127; vs[idx] = bf2f(Z[(size_t)(row0 + t) * ZW + ZMV + hh * 128 + ee]); }
    if (tp < 64) s_n[tp] = p.st_n[unit * 64 + tp];
    if (tp == 0) {
        const float mprev = p.st_m[unit];
        float bt = 0.f, cm = -INFINITY;
        for (int t = 0; t < 8; ++t) {
            const float lf = GT[(size_t)(row0 + t) * 8 + 4 + hh], ig = GT[(size_t)(row0 + t) * 8 + hh];
            bt += lf; const float a = ig - bt; cm = fmaxf(cm, a);
            const float mt = bt + fmaxf(cm, mprev);
            s_a[t] = a; s_bt[t] = bt; s_mt[t] = mt; s_wi[t] = __expf(bt + mprev - mt);
        }
        const float bL = bt, mnew = s_mt[7];
        for (int t = 0; t < 8; ++t) s_wk[t] = __expf(s_a[t] + bL - mnew);
        s_misc[0] = __expf(bL + mprev - mnew);
        p.out[O_MS + unit] = mnew;
    }
    __syncthreads();
    if (tp < 64) { const int l = tp >> 3, s = tp & 7; float a = 0.f;
#pragma unroll 8
        for (int d = 0; d < 64; ++d) a += qs[l * 64 + d] * ks[s * 64 + d];
        Ss[tp] = (s <= l) ? a * __expf(s_a[s] + s_bt[l] - s_mt[l]) : 0.f; }
    float* n2s = red + 16;
#pragma unroll 1
    for (int l = 0; l < 8; ++l) { float a = 0.f;
#pragma unroll
        for (int i = 0; i < 16; ++i) { const f32x4 q4 = *(const f32x4*)(qs + l * 64 + 4 * i); a += q4[0] * C4[i][0] + q4[1] * C4[i][1] + q4[2] * C4[i][2] + q4[3] * C4[i][3]; }
        n2s[l * 128 + e] = a; }
    __syncthreads();
    if (tp < 8) { float dn = 0.f; for (int s = 0; s < 8; ++s) dn += Ss[tp * 8 + s]; float qn = 0.f;
#pragma unroll 8
        for (int d = 0; d < 64; ++d) qn += qs[tp * 64 + d] * s_n[d];
        dn += s_wi[tp] * qn; s_den[tp] = fmaxf(fabsf(dn), __expf(-s_mt[tp])); }
    float hv[8];
#pragma unroll
    for (int l = 0; l < 8; ++l) { float n1 = 0.f;
#pragma unroll
        for (int s = 0; s < 8; ++s) n1 += Ss[l * 8 + s] * vs[s * 128 + e];
        hv[l] = n1 + s_wi[l] * n2s[l * 128 + e]; }
    __syncthreads();
#pragma unroll
    for (int l = 0; l < 8; ++l) { hv[l] = hv[l] / s_den[l]; const float ss = wave_sum(hv[l] * hv[l]); if (lane == 0) red[l * 2 + wv] = ss; }
    __syncthreads();
#pragma unroll
    for (int l = 0; l < 8; ++l) {
        const float rstd = rsqrtf((red[l * 2] + red[l * 2 + 1]) * (1.0f / 128.0f) + 1e-6f);
        const float og = bf2f(Z[(size_t)(row0 + l) * ZW + ZOG + hh * 128 + e]);
        const float o = hv[l] * rstd * p.g_head[hh * 128 + e] / (1.0f + __expf(-og));
        CAT[(size_t)(row0 + l) * D + 512 + hh * 128 + e] = (bf16_t)(pk_bf16(o, o) & 0xffffu);
    }
    { const float wc = s_misc[0]; float vw[8];
#pragma unroll
      for (int s = 0; s < 8; ++s) vw[s] = s_wk[s] * vs[s * 128 + e];
      float* Cout = p.out + O_CS + (size_t)unit * 8192 + e * 64;
#pragma unroll
      for (int i = 0; i < 16; ++i) { f32x4 c = C4[i] * wc;
#pragma unroll
          for (int s = 0; s < 8; ++s) c += *(const f32x4*)(ks + s * 64 + 4 * i) * vw[s];
          *(f32x4*)(Cout + 4 * i) = c;
          asm volatile("" ::: "memory"); }
      if (tp < 64) { float nn = wc * s_n[tp];
#pragma unroll
          for (int s = 0; s < 8; ++s) nn += s_wk[s] * ks[s * 64 + tp];
          p.out[O_NS + unit * 64 + tp] = nn; } }
    __syncthreads();
}

__device__ __forceinline__ void rms_final(const Params& p) {
    const int tid = opaque_tid(), lane = tid & 63, wid = tid >> 6;
    float* Y = p.out + O_Y;
    const bf16_t* XB = (const bf16_t*)(p.ws + WS_XN);
    const int stride = gridDim.x * 8;
    for (int row0 = blockIdx.x * 8 + wid; row0 < M; row0 += 2 * stride) {
        f32x4 v[2][4];
#pragma unroll
        for (int q = 0; q < 2; ++q) { const int row = row0 + q * stride;
            if (row < M) {
                const bf16_t* xb = XB + (size_t)row * D;
#pragma unroll
                for (int i = 0; i < 4; ++i) { const u32x2 w = *(const u32x2*)(xb + 4 * (lane + 64 * i)); v[q][i] = (f32x4){bf_lo(w[0]), bf_hi(w[0]), bf_lo(w[1]), bf_hi(w[1])}; }
                if (row >= MP) {
                    const bf16_t* sb = (const bf16_t*)(p.ws + WS_SLAB) + (size_t)(row - MP) * D;
#pragma unroll
                    for (int s = 0; s < 11; ++s)
#pragma unroll
                        for (int i = 0; i < 4; ++i) { const u32x2 w = *(const u32x2*)(sb + (size_t)s * MS * D + 4 * (lane + 64 * i)); v[q][i] += (f32x4){bf_lo(w[0]), bf_hi(w[0]), bf_lo(w[1]), bf_hi(w[1])}; }
                }
            } else {
#pragma unroll
                for (int i = 0; i < 4; ++i) v[q][i] = (f32x4){0.f, 0.f, 0.f, 0.f};
            } }
        f32x4 gv[4];
#pragma unroll
        for (int i = 0; i < 4; ++i) gv[i] = *(const f32x4*)(p.g_final + 4 * (lane + 64 * i));
#pragma unroll
        for (int q = 0; q < 2; ++q) { const int row = row0 + q * stride;
            float ss = 0.f;
#pragma unroll
            for (int i = 0; i < 4; ++i) ss += v[q][i][0] * v[q][i][0] + v[q][i][1] * v[q][i][1] + v[q][i][2] * v[q][i][2] + v[q][i][3] * v[q][i][3];
            ss = wave_sum(ss);
            const float rstd = rsqrtf(ss * (1.0f / D) + 1e-6f);
            if (row < M) {
#pragma unroll
                for (int i = 0; i < 4; ++i) __builtin_nontemporal_store(v[q][i] * rstd * gv[i], (f32x4*)(Y + (size_t)row * D + 4 * (lane + 64 * i)));
            } }
    }
}


#define XB_TMO      128
#define XB_XCNT(j)  (256  + 64 * (j))
#define XB_XSUB(j)  (1280 + 64 * (j))
#define XB_XGEN(j)  (2304 + 64 * (j))
#define XB_TOP      3328
#define XB_TOPGEN   3392
#define XCD_BAR_WORDS 3456
#define XB_SPIN_CAP (1u << 18)
__device__ __forceinline__ unsigned xb_ld(unsigned* p)              { return __hip_atomic_load(p, __ATOMIC_RELAXED, __HIP_MEMORY_SCOPE_AGENT); }
__device__ __forceinline__ unsigned xb_add(unsigned* p, unsigned v) { return __hip_atomic_fetch_add(p, v, __ATOMIC_RELAXED, __HIP_MEMORY_SCOPE_AGENT); }
__device__ __forceinline__ unsigned xb_xcc_id() { return (unsigned)__builtin_amdgcn_s_getreg((3 << 11) | 20) & 0xFu; }
#define XB_SPIN(cond, bar) do { unsigned _sp = 0; while (cond) { __builtin_amdgcn_s_sleep(1); \
    if ((++_sp & 255u) == 0u) { if (xb_ld(&(bar)[XB_TMO])) break; if (_sp > XB_SPIN_CAP) { atomicAdd(&(bar)[XB_TMO], 1u); break; } } } } while (0)
struct XcdBarrier { unsigned* bar; unsigned x; volatile LAS unsigned* st; };
__device__ __forceinline__ XcdBarrier xcd_barrier_post(unsigned* bar, volatile LAS unsigned* st) {
    XcdBarrier b; b.bar = bar; b.x = xb_xcc_id(); b.st = st;
    if (threadIdx.x == 0) (void)xb_add(&bar[XB_XCNT(b.x)], 1u);
    return b;
}
__device__ __forceinline__ void xcd_barrier_complete(unsigned* bar, unsigned x, unsigned& nloc, unsigned& nx) {
    const unsigned G = gridDim.x * gridDim.y * gridDim.z;
    unsigned sum, cnt, mine, sp = 0u;
    for (;;) {
        sum = 0u; cnt = 0u; mine = 0u;
#pragma unroll
        for (unsigned j = 0; j < 16; ++j) { const unsigned c = xb_ld(&bar[XB_XCNT(j)]); sum += c; cnt += (c > 0u) ? 1u : 0u; mine = (j == x) ? c : mine; }
        if (sum == G) break;
        __builtin_amdgcn_s_sleep(1);
        if ((++sp & 255u) == 0u) { if (xb_ld(&bar[XB_TMO])) break; if (sp > XB_SPIN_CAP) { atomicAdd(&bar[XB_TMO], 1u); break; } }
    }
    nloc = mine > 0u ? mine : 1u; nx = cnt > 0u ? cnt : 1u;
}
__device__ __forceinline__ void xcd_barrier(const XcdBarrier& b) {
    asm volatile("s_waitcnt vmcnt(0)" ::: "memory");
    __syncthreads();
    if (threadIdx.x == 0) {
        unsigned* bar = b.bar;
        __builtin_amdgcn_s_waitcnt(0);
        unsigned nloc = b.st[0], nx = b.st[1];
        if (nloc == 0u) { xcd_barrier_complete(bar, b.x, nloc, nx); b.st[0] = nloc; b.st[1] = nx; }
        const unsigned old = xb_add(&bar[XB_XSUB(b.x)], 1u);
        const unsigned gen = old / nloc;
        if (old + 1u == (gen + 1u) * nloc) {
            __builtin_amdgcn_fence(__ATOMIC_RELEASE, "agent");
            asm volatile("s_waitcnt vmcnt(0)" ::: "memory");
            const unsigned og = xb_add(&bar[XB_TOP], 1u);
            const unsigned tg = og / nx;
            if (og + 1u == (tg + 1u) * nx) xb_add(&bar[XB_TOPGEN], 1u);
            else XB_SPIN(xb_ld(&bar[XB_TOPGEN]) == tg, bar);
            __builtin_amdgcn_fence(__ATOMIC_ACQUIRE, "agent");
            xb_add(&bar[XB_XGEN(b.x)], 1u);
            asm volatile("s_waitcnt vmcnt(0)" ::: "memory");
        } else {
            XB_SPIN(xb_ld(&bar[XB_XGEN(b.x)]) == gen, bar);
            __builtin_amdgcn_fence(__ATOMIC_ACQUIRE, "agent");
            asm volatile("s_waitcnt vmcnt(0)" ::: "memory");
        }
    }
    __syncthreads();
}

__global__ void __launch_bounds__(NTHREADS, 2) fwd_megakernel(Params p) {
    extern __shared__ __attribute__((aligned(16))) unsigned char shm[];
    cg::grid_group grid = cg::this_grid();
    const int G = gridDim.x, bid = blockIdx.x, tid = threadIdx.x;
    bf16_t* XN = (bf16_t*)(p.ws + WS_XN);

    volatile LAS unsigned* xst = (volatile LAS unsigned*)((LAS unsigned char*)shm + LDS_BYTES - 16);
    if (tid == 0) { xst[0] = 0u; xst[1] = 0u; }
    __syncthreads();
    const XcdBarrier xbar = xcd_barrier_post((unsigned*)(p.ws + WS_BAR), xst);
    const bool late_tiles = (G == 256);
    phase0(p, shm, !late_tiles);
    if (p.out == nullptr) grid.sync();
    xcd_barrier(xbar);
#define RUN_GEMM(GG, EE, CSH) do { const pg8::Gemm g_ = GG; const Epi E_ = EE; pg8::StaticOrder S_; S_.init(g_.M, g_.N, G, (bid + (CSH)) % G); gemm_phase(p, (LAS unsigned char*)shm, g_, S_, E_); } while (0)
    RUN_GEMM((pg8::Gemm{XN, (const bf16_t*)(p.ws + WS_WIN), M, ZW, D, D}), (Epi{EM_BF16, 1, ZW, (bf16_t*)(p.ws + WS_Z), nullptr, nullptr, nullptr}), 0);
    RUN_GEMM((pg8::Gemm{(const bf16_t*)(p.ws + WS_MN), (const bf16_t*)(p.ws + WS_WCKV), 1024, 512, D, D}), (Epi{EM_MEMKV, 0, 512, (bf16_t*)(p.ws + WS_MEMKV), nullptr, nullptr, nullptr}), 128);
    if (late_tiles && bid >= 100 && !(bid >= 128 && bid < 136)) conv_tiles(p, shm, T_EARLY, T_MID, bid < 128 ? bid - 100 : bid - 108, 148);
    xcd_barrier(xbar);
    {
        for (int u = bid; u < 256; u += G) swa_prompt_unit(p, shm, u);
        for (int u = bid; u < NUNIT / 4; u += G) mlstm_local_group(p, shm, u);
        for (int u = bid; u < 256; u += G) { if (u < 128) mlstm_sample_group(p, shm, u); else swa_sample_unit(p, shm, u - 128); }
        const bf16_t* Z = (const bf16_t*)(p.ws + WS_Z);
        for (int idx = bid * NTHREADS + tid; idx < 4 * 128 * 128; idx += G * NTHREADS) {
            const int col = idx & 127, j = (idx >> 7) & 127, b = idx >> 14;
            const bf16_t* zr = Z + (size_t)(b * SEQ + SEQ - 128 + j) * ZW;
            p.out[O_SKP + idx] = bf2f(zr[ZK + col]); p.out[O_SVP + idx] = bf2f(zr[ZV + col]); }
    }
    xcd_barrier(xbar);
    mlstm_scan(p);
    xcd_barrier(xbar);
    for (int u = bid; u < NUNIT / 4; u += G) mlstm_out_group(p, shm, u);
    xcd_barrier(xbar);
    float* SSQ1 = (float*)(p.ws + WS_SSQ1); float* SSQ2 = (float*)(p.ws + WS_SSQ2);
    RUN_GEMM((pg8::Gemm{(const bf16_t*)(p.ws + WS_CAT), (const bf16_t*)(p.ws + WS_WOUT), M, D, D, D}), (Epi{EM_RES_X, 0, D, XN, nullptr, nullptr, SSQ1}), 0);
    xcd_barrier(xbar);
    RUN_GEMM((pg8::Gemm{XN, (const bf16_t*)(p.ws + WS_WCQ), M, 256, D, D}), (Epi{EM_BF16, 1, 256, (bf16_t*)(p.ws + WS_Q2), nullptr, nullptr, SSQ1}), 0);
    if (late_tiles && bid >= 68) conv_tiles(p, shm, T_MID, T_ALL, bid - 68, 188);
    xcd_barrier(xbar);
    {
        for (int u = bid; u < 256; u += G) cross_prompt_unit(p, shm, u);
        for (int u = bid; u < 512; u += G) cross_sample_unit(p, shm, u);
    }
    xcd_barrier(xbar);
    const bool split_co = (G == 256);
    RUN_GEMM((pg8::Gemm{(const bf16_t*)(p.ws + WS_O2), (const bf16_t*)(p.ws + WS_WCO), split_co ? MP : M, D, 256, 256}), (Epi{EM_RES_Y, 0, D, XN, nullptr, nullptr, SSQ2}), 0);
    xcd_barrier(xbar);
    unsigned* DEP = (unsigned*)(p.ws + WS_DEP);
    if (split_co && bid >= 240) {
        const int tl = bid - 240;
        const pg8::Gemm g_ = {(const bf16_t*)(p.ws + WS_O2), (const bf16_t*)(p.ws + WS_WCO), M, D, 256, 256};
        const Epi E_ = {EM_RES_Y, 0, D, XN, nullptr, nullptr, SSQ2};
        pg8::StaticOrder S_; S_.init(M, D, G, 0); S_.spm = 64 + (tl >> 2); S_.spn = tl & 3;
        gemm_phase(p, (LAS unsigned char*)shm, g_, S_, E_);
        asm volatile("s_waitcnt vmcnt(0)" ::: "memory");
        __syncthreads();
        if (tid == 0) { __builtin_amdgcn_fence(__ATOMIC_RELEASE, "agent"); asm volatile("s_waitcnt vmcnt(0)" ::: "memory");
            (void)__hip_atomic_fetch_add(DEP, 1u, __ATOMIC_RELAXED, __HIP_MEMORY_SCOPE_AGENT); }
    }
    RUN_GEMM((pg8::Gemm{XN, (const bf16_t*)(p.ws + WS_WGU), M, 2 * FFN, D, D}), (Epi{EM_SWIGLU, 1, FFN, (bf16_t*)(p.ws + WS_H), nullptr, split_co ? DEP : nullptr, SSQ2}), 0);
    xcd_barrier(xbar);
    RUN_GEMM((pg8::Gemm{(const bf16_t*)(p.ws + WS_H), (const bf16_t*)(p.ws + WS_WD), MP, D, FFN, FFN}), (Epi{EM_RES_Y, 0, D, XN, nullptr, nullptr, nullptr}), 0);
    {
        const int su = (bid + 80) % G;
        const int sl = su >> 4, tl = su & 15;
        const pg8::Gemm g_ = {(const bf16_t*)(p.ws + WS_H) + sl * 256, (const bf16_t*)(p.ws + WS_WD) + sl * 256, M, D, 256, FFN};
        const Epi E_ = {EM_SLAB, 0, D, nullptr, (float*)((bf16_t*)(p.ws + WS_SLAB) + (size_t)sl * MS * D), nullptr, nullptr};
        pg8::StaticOrder S_; S_.init(M, D, G, su < 176 ? 0 : -1); S_.spm = 64 + (tl >> 2); S_.spn = tl & 3;
        gemm_phase(p, (LAS unsigned char*)shm, g_, S_, E_);
    }
    xcd_barrier(xbar);
    rms_final(p);
}

extern "C" void kernel_launch(void* const* d_in, const int* in_sizes, int n_in, void* d_out, int out_size, void* d_ws, size_t ws_size, hipStream_t stream) {
    static int grid = 0;
    if (grid == 0) {
        int dev = 0, cus = 0, per_cu = 0;
        (void)hipGetDevice(&dev);
        (void)hipDeviceGetAttribute(&cus, hipDeviceAttributeMultiprocessorCount, dev);
        (void)hipFuncSetAttribute((const void*)fwd_megakernel, hipFuncAttributeMaxDynamicSharedMemorySize, LDS_BYTES);
        (void)hipOccupancyMaxActiveBlocksPerMultiprocessor(&per_cu, (const void*)fwd_megakernel, NTHREADS, LDS_BYTES);
        if (per_cu < 1) per_cu = 1;
        if (per_cu > 1) per_cu = 1;
        grid = cus * per_cu;
        if (ws_size < WS_END || n_in != 28 || (size_t)out_size != O_END) fprintf(stderr, "kernel_launch: unexpected sizes ws %zu (need %zu) n_in %d out %d\n", ws_size, (size_t)WS_END, n_in, out_size);
    }
    Params p{};
    const float** pp = (const float**)&p;
    for (int i = 0; i < 28; ++i) pp[i] = (const float*)d_in[i];
    p.out = (float*)d_out; p.ws = (unsigned char*)d_ws;
    (void)hipMemsetAsync((unsigned char*)d_ws + WS_BAR, 0, WS_ZERO_BYTES, stream);
    void* args[] = {&p};
    hipError_t e = hipLaunchCooperativeKernel((const void*)fwd_megakernel, dim3(grid), dim3(NTHREADS), args, LDS_BYTES, stream);
    if (e != hipSuccess) fprintf(stderr, "cooperative launch failed: %s (grid %d)\n", hipGetErrorString(e), grid);
}
```

```cpp
#include <hip/hip_runtime.h>
#include <hip/hip_cooperative_groups.h>
#include <cstdio>
#include <cstdint>
namespace cg = cooperative_groups;

#define LAS __attribute__((address_space(3)))
typedef unsigned short bf16_t;
typedef short bf16x8 __attribute__((ext_vector_type(8)));
typedef short bf16x4 __attribute__((ext_vector_type(4)));
typedef float f32x4 __attribute__((ext_vector_type(4)));
typedef float f32x16 __attribute__((ext_vector_type(16)));
typedef unsigned u32x4 __attribute__((ext_vector_type(4)));
typedef unsigned u32x2 __attribute__((ext_vector_type(2)));

constexpr int D = 1024, MP = 16384, MS = 1024, M = MP + MS, SEQ = 4096;
constexpr int INW = 2312, ZW = 2304, FFN = 2816;
constexpr int ZQ = 0, ZK = 512, ZV = 640, ZMQ = 768, ZMK = 1024, ZMV = 1280, ZOG = 1792;
constexpr int NUNIT = 1024;
constexpr size_t O_Y = 0, O_SKP = (size_t)M * D, O_SVP = O_SKP + 65536, O_CP = O_SVP + 65536, O_NP = O_CP + 131072, O_MP = O_NP + 1024,
                 O_MKP = O_MP + 16, O_MVP = O_MKP + 262144, O_SKS = O_MVP + 262144, O_SVS = O_SKS + 2097152, O_CS = O_SVS + 2097152,
                 O_NS = O_CS + 4194304, O_MS = O_NS + 32768, O_END = O_MS + 512;
constexpr size_t al256(size_t x) { return (x + 255) & ~(size_t)255; }
constexpr size_t WS_WIN = 0;
constexpr size_t WS_WOUT = WS_WIN + (size_t)ZW * D * 2;
constexpr size_t WS_WCQ = WS_WOUT + (size_t)D * D * 2;
constexpr size_t WS_WCKV = WS_WCQ + (size_t)256 * D * 2;
constexpr size_t WS_WCO = WS_WCKV + (size_t)512 * D * 2;
constexpr size_t WS_WGU = WS_WCO + (size_t)D * 256 * 2;
constexpr size_t WS_WD = WS_WGU + (size_t)2 * FFN * D * 2;
constexpr size_t WS_XN = WS_WD + (size_t)D * FFN * 2;
constexpr size_t WS_MN = WS_XN + (size_t)M * D * 2;
constexpr size_t WS_GATES = WS_MN + (size_t)1024 * D * 2;
constexpr size_t WS_MEMKV = WS_GATES + (size_t)M * 8 * 4;
constexpr size_t WS_SCAL = WS_MEMKV + (size_t)1024 * 512 * 2;
constexpr size_t WS_NT = WS_SCAL + 3 * 4096;
constexpr size_t WS_NPREV = WS_NT + (size_t)NUNIT * 64 * 4;
constexpr size_t WS_Z = WS_NPREV + (size_t)NUNIT * 64 * 4;
constexpr size_t WS_CAT = WS_Z + (size_t)M * ZW * 2;
constexpr size_t WS_H = WS_Z;
constexpr size_t WS_UT = WS_CAT + (size_t)M * D * 2;
constexpr size_t WS_Q2 = WS_UT;
constexpr size_t WS_O2 = WS_Q2 + (size_t)M * 256 * 2;
constexpr size_t WS_SLAB = WS_UT;
constexpr size_t WS_CPREV = WS_UT + (size_t)NUNIT * 8192 * 4;
constexpr size_t WS_BAR = WS_CPREV + (size_t)NUNIT * 8192 * 2;
constexpr size_t WS_SSQ1 = WS_BAR + 16384;
constexpr size_t WS_SSQ2 = WS_SSQ1 + (size_t)M * 4;
constexpr size_t WS_DEP = WS_SSQ2 + (size_t)M * 4;
constexpr size_t WS_ZERO_BYTES = 16384 + 2 * (size_t)M * 4 + 256;
constexpr size_t WS_END = WS_DEP + 256;
static_assert((size_t)M * FFN * 2 <= (size_t)M * ZW * 2 + (size_t)M * D * 2, "H overlay");
static_assert(WS_END <= (size_t)256 * 1024 * 1024, "workspace");
static_assert((size_t)11 * MS * D * 4 <= (size_t)NUNIT * 8192 * 4 + (size_t)NUNIT * 8192 * 2, "slab overlay");

constexpr int LDS_BYTES = 140 * 1024;
constexpr int NTHREADS = 512;

struct Params {
    const float *x_prompt, *x_sample, *mem_prompt, *cache_swa_k, *cache_swa_v, *st_C, *st_n, *st_m, *cache_mem_k, *cache_mem_v,
        *w_in, *b_ig, *b_fg, *sinks, *g_head, *w_out, *g_mix, *g_cross, *g_mem, *w_cq, *w_ck, *w_cv, *w_co, *g_ffn, *w_gate, *w_up, *w_down, *g_final;
    float* out;
    unsigned char* ws;
};

__device__ __forceinline__ unsigned pk_bf16(float lo, float hi) { unsigned r; asm volatile("v_cvt_pk_bf16_f32 %0, %1, %2" : "=v"(r) : "v"(lo), "v"(hi)); return r; }
__device__ __forceinline__ float bf_lo(unsigned u) { return __uint_as_float(u << 16); }
__device__ __forceinline__ float bf_hi(unsigned u) { return __uint_as_float(u & 0xffff0000u); }
__device__ __forceinline__ float bf2f(bf16_t b) { return __uint_as_float(((unsigned)b) << 16); }
__device__ __forceinline__ const float* xrow(const Params& p, int r) { return r < MP ? p.x_prompt + (size_t)r * D : p.x_sample + (size_t)(r - MP) * D; }
__device__ __forceinline__ int opaque_tid() { int t = threadIdx.x; asm volatile("" : "+v"(t)); return t; }
__device__ __forceinline__ float wave_sum(float v) {
#pragma unroll
    for (int o = 32; o > 0; o >>= 1) v += __shfl_xor(v, o);
    return v;
}
__device__ __forceinline__ float wave_max(float v) {
#pragma unroll
    for (int o = 32; o > 0; o >>= 1) v = fmaxf(v, __shfl_xor(v, o));
    return v;
}
__device__ __forceinline__ float wave_scan_add(float v, int lane) {
#pragma unroll
    for (int o = 1; o < 64; o <<= 1) { float t = __shfl_up(v, o); if (lane >= o) v += t; }
    return v;
}
__device__ __forceinline__ float wave_scan_max(float v, int lane) {
#pragma unroll
    for (int o = 1; o < 64; o <<= 1) { float t = __shfl_up(v, o); if (lane >= o) v = fmaxf(v, t); }
    return v;
}

namespace pg8 {
constexpr int BM = 256, BK = 64, HALF = 128, HTB = HALF * BK * 2, STAGE_BYTES = 8 * HTB, NXCD = 8, WGM = 8;
__device__ __forceinline__ int lds_byte(int r, int c) { const int st = (r >> 4) * 2 + (c >> 5), rr = r & 15, cc = c & 31, ob = rr * 64 + cc * 2; return st * 1024 + (ob ^ (((ob >> 9) & 1) << 5)); }
__device__ __forceinline__ void stage_rc(int b, int& R, int& C) { const int st = b / 1024, sb = b % 1024, swz = sb ^ (((sb >> 9) & 1) << 5); R = (st >> 1) * 16 + swz / 64; C = (st & 1) * 32 + (swz % 64) / 2; }
__device__ __forceinline__ int perm32(int rho) { const int n = rho >> 4, i = rho & 15; return 8 * (i >> 2) + 4 * n + (i & 3); }
struct Unit { int pm, pn; };
struct Gemm { const bf16_t* A; const bf16_t* Bt; int M, N, K, ld; };
struct StaticOrder {
    int nM, nN, nwg, G, c, spm, spn;
    __device__ void init(int M_, int N_, int G_, int c_) { nM = M_ / BM; nN = N_ / BM; nwg = nM * nN; G = G_; c = c_; spm = -1; spn = 0; }
    __device__ bool next(int i, Unit& u) const {
        if (spm >= 0) { if (i > 0 || c < 0) return false; u.pm = spm; u.pn = spn; return true; }
        const long L = (long)i * G + c; if (L >= nwg) return false;
        int wgid = (int)L; { const int q = nwg / NXCD, r = nwg % NXCD, xcd = wgid % NXCD, off = wgid / NXCD; wgid = (xcd < r ? xcd * (q + 1) : r * (q + 1) + (xcd - r) * q) + off; }
        const int nig = WGM * nN, gid = wgid / nig, fm = gid * WGM, gsz = (nM - fm) < WGM ? (nM - fm) : WGM;
        u.pm = fm + ((wgid % nig) % gsz); u.pn = (wgid % nig) / gsz; return true;
    }
};
}

enum { EM_BF16 = 0, EM_SWIGLU = 1, EM_RES_X = 2, EM_RES_Y = 3, EM_MEMKV = 4, EM_DUMMY = 5, EM_SLAB = 6 };
struct Epi {
    int mode, perm, ldc;
    bf16_t* O;
    float* Y;
    unsigned* dep;
    float* ssq;
};

__device__ __forceinline__ float silu_f(float g) { return g * __builtin_amdgcn_rcpf(1.0f + __expf(-g)); }

__device__ __forceinline__ void epi_apply(const Params& p, const Epi& E, const f32x4 (&acc)[2][2][4][2], const pg8::Unit& u, int wr, int wc, int fr, int fq) {
    const int row0 = u.pm * 256 + wr * 64 + fr;
    if (E.mode == EM_BF16) {
        const int col0 = u.pn * 256 + wc * 32 + 8 * fq;
        float rsv[2][4];
#pragma unroll
        for (int ai = 0; ai < 2; ++ai)
#pragma unroll
            for (int m = 0; m < 4; ++m) rsv[ai][m] = E.ssq ? E.ssq[row0 + ai * 128 + m * 16] : 0.f;
#pragma unroll
        for (int ai = 0; ai < 2; ++ai)
#pragma unroll
            for (int m = 0; m < 4; ++m) {
                bf16_t* rowp = E.O + (size_t)(row0 + ai * 128 + m * 16) * E.ldc + col0;
                const float rs = E.ssq ? rsqrtf(rsv[ai][m] * (1.0f / D) + 1e-6f) : 1.0f;
#pragma unroll
                for (int bj = 0; bj < 2; ++bj) {
                    const f32x4 v0 = acc[ai][bj][m][0] * rs, v1 = acc[ai][bj][m][1] * rs;
                    u32x4 o; o[0] = pk_bf16(v0[0], v0[1]); o[1] = pk_bf16(v0[2], v0[3]); o[2] = pk_bf16(v1[0], v1[1]); o[3] = pk_bf16(v1[2], v1[3]);
                    *(u32x4*)(rowp + bj * 128) = o;
                }
            }
    } else if (E.mode == EM_SWIGLU) {
        const int col0 = u.pn * 128 + wc * 32 + 8 * fq;
        float rsv[2][4];
#pragma unroll
        for (int ai = 0; ai < 2; ++ai)
#pragma unroll
            for (int m = 0; m < 4; ++m) rsv[ai][m] = E.ssq ? E.ssq[row0 + ai * 128 + m * 16] : 0.f;
#pragma unroll
        for (int ai = 0; ai < 2; ++ai)
#pragma unroll
            for (int m = 0; m < 4; ++m) {
                bf16_t* rowp = E.O + (size_t)(row0 + ai * 128 + m * 16) * E.ldc + col0;
                const float rs = E.ssq ? rsqrtf(rsv[ai][m] * (1.0f / D) + 1e-6f) : 1.0f;
                const f32x4 g0 = acc[ai][0][m][0] * rs, g1 = acc[ai][0][m][1] * rs, u0 = acc[ai][1][m][0] * rs, u1 = acc[ai][1][m][1] * rs;
                u32x4 o;
                o[0] = pk_bf16(silu_f(g0[0]) * u0[0], silu_f(g0[1]) * u0[1]); o[1] = pk_bf16(silu_f(g0[2]) * u0[2], silu_f(g0[3]) * u0[3]);
                o[2] = pk_bf16(silu_f(g1[0]) * u1[0], silu_f(g1[1]) * u1[1]); o[3] = pk_bf16(silu_f(g1[2]) * u1[2], silu_f(g1[3]) * u1[3]);
                *(u32x4*)rowp = o;
            }
    } else if (E.mode == EM_RES_X || E.mode == EM_RES_Y) {
        const int col0 = u.pn * 256 + wc * 32 + 8 * fq;
        float ssr[2][4];
#pragma unroll
        for (int ai = 0; ai < 2; ++ai) {
            f32x4 rr[4][2][2];
#pragma unroll
            for (int m = 0; m < 4; ++m) {
                const int row = row0 + ai * 128 + m * 16;
                if (E.mode == EM_RES_X) {
                    const float* rp = xrow(p, row) + col0;
#pragma unroll
                    for (int bj = 0; bj < 2; ++bj)
#pragma unroll
                        for (int n = 0; n < 2; ++n) rr[m][bj][n] = *(const f32x4*)(rp + bj * 128 + n * 4);
                } else {
                    const bf16_t* rp = E.O + (size_t)row * D + col0;
#pragma unroll
                    for (int bj = 0; bj < 2; ++bj) { const u32x4 q = *(const u32x4*)(rp + bj * 128);
                        rr[m][bj][0] = (f32x4){bf_lo(q[0]), bf_hi(q[0]), bf_lo(q[1]), bf_hi(q[1])}; rr[m][bj][1] = (f32x4){bf_lo(q[2]), bf_hi(q[2]), bf_lo(q[3]), bf_hi(q[3])}; }
                }
            }
#pragma unroll
            for (int m = 0; m < 4; ++m) {
                const int row = row0 + ai * 128 + m * 16;
                float ss = 0.f;
#pragma unroll
                for (int bj = 0; bj < 2; ++bj) {
                    const f32x4 y0 = acc[ai][bj][m][0] + rr[m][bj][0], y1 = acc[ai][bj][m][1] + rr[m][bj][1];
                    if (E.Y) { *(f32x4*)(E.Y + (size_t)row * D + col0 + bj * 128) = y0; *(f32x4*)(E.Y + (size_t)row * D + col0 + bj * 128 + 4) = y1; }
                    else { u32x4 o; o[0] = pk_bf16(y0[0], y0[1]); o[1] = pk_bf16(y0[2], y0[3]); o[2] = pk_bf16(y1[0], y1[1]); o[3] = pk_bf16(y1[2], y1[3]); *(u32x4*)(E.O + (size_t)row * D + col0 + bj * 128) = o; }
                    ss += y0[0] * y0[0] + y0[1] * y0[1] + y0[2] * y0[2] + y0[3] * y0[3] + y1[0] * y1[0] + y1[1] * y1[1] + y1[2] * y1[2] + y1[3] * y1[3];
                }
                ssr[ai][m] = ss;
            }
        }
        if (E.ssq) {
#pragma unroll
            for (int ai = 0; ai < 2; ++ai)
#pragma unroll
                for (int m = 0; m < 4; ++m) { float ss = ssr[ai][m]; ss += __shfl_xor(ss, 16); ss += __shfl_xor(ss, 32);
                    if (fq == 0) (void)__hip_atomic_fetch_add(E.ssq + row0 + ai * 128 + m * 16, ss, __ATOMIC_RELAXED, __HIP_MEMORY_SCOPE_AGENT); }
        }
    } else if (E.mode == EM_SLAB) {
        const int col0 = u.pn * 256 + wc * 32 + 4 * fq;
#pragma unroll
        for (int ai = 0; ai < 2; ++ai)
#pragma unroll
            for (int m = 0; m < 4; ++m) {
                bf16_t* yp = (bf16_t*)E.Y + (size_t)(row0 - MP + ai * 128 + m * 16) * D + col0;
#pragma unroll
                for (int bj = 0; bj < 2; ++bj)
#pragma unroll
                    for (int n = 0; n < 2; ++n) { const f32x4 a = acc[ai][bj][m][n]; u32x2 o; o[0] = pk_bf16(a[0], a[1]); o[1] = pk_bf16(a[2], a[3]); *(u32x2*)(yp + bj * 128 + n * 16) = o; }
            }
    } else if (E.mode == EM_DUMMY) {
        if (acc[0][0][0][0][0] == 12345.678f && acc[1][1][3][1][3] == -777.25f) E.Y[row0] = acc[0][1][2][0][1];
    } else {
        const int col0 = u.pn * 256 + wc * 32 + 4 * fq;
        float* ob = p.out + (u.pn == 0 ? O_MKP : O_MVP);
#pragma unroll
        for (int ai = 0; ai < 2; ++ai)
#pragma unroll
            for (int m = 0; m < 4; ++m) {
                const int row = row0 + ai * 128 + m * 16;
#pragma unroll
                for (int bj = 0; bj < 2; ++bj)
#pragma unroll
                    for (int n = 0; n < 2; ++n) {
                        const int c = col0 + bj * 128 + n * 16;
                        const f32x4 v = acc[ai][bj][m][n];
                        *(f32x4*)(ob + (size_t)row * 256 + (c & 255)) = v;
                        u32x2 o; o[0] = pk_bf16(v[0], v[1]); o[1] = pk_bf16(v[2], v[3]);
                        *(u32x2*)(E.O + (size_t)row * 512 + c) = o;
                    }
            }
    }
}

__device__ __forceinline__ void gemm_phase(const Params& p, LAS unsigned char* lds, const pg8::Gemm g, const pg8::StaticOrder& S, const Epi& E) {
    using namespace pg8;
    int tid_ = threadIdx.x; asm volatile("" : "+v"(tid_));
    const int tid = tid_, wid = __builtin_amdgcn_readfirstlane(tid >> 6), lane = tid & 63, wr = wid >> 2, wc = wid & 3, fr = lane & 15, fq = lane >> 4;
    const int K = g.K, nt = K / BK;
    unsigned voffA[2], voffB[2];
#pragma unroll
    for (int i = 0; i < 2; ++i) { int R, C; stage_rc(tid * 16 + i * 8192, R, C); const int Rb = E.perm ? ((R & ~31) + perm32(R & 31)) : R;
        voffA[i] = (unsigned)(R * g.ld + C) * 2u; voffB[i] = (unsigned)(Rb * g.ld + C) * 2u; }
    const size_t kstep = (size_t)(BK * 2);
    const size_t hstep = (size_t)HALF * g.ld * 2;
    const size_t tstep = 2 * hstep;
    const unsigned ldsw = (unsigned)wid * 1024u;
    const int aoff = lds_byte(wr * 64 + fr, fq * 8), boff = lds_byte(wc * 32 + fr, fq * 8);
#define PG8_SA(b, h) (((b) * 2 + (h)) * HTB)
#define PG8_SB(b, h) ((4 + (b) * 2 + (h)) * HTB)
#define PG8_STAGE(bufoff, gbase, voff) do { _Pragma("unroll") for (int _i = 0; _i < 2; ++_i) \
        __builtin_amdgcn_global_load_lds((const unsigned*)((const char*)(gbase) + (voff)[_i]), (LAS unsigned*)(lds + (bufoff) + ldsw + _i * 8192), 16, 0, 0); } while (0)
#define PG8_LDA(dst, b, h) do { _Pragma("unroll") for (int m = 0; m < 4; ++m) _Pragma("unroll") for (int k = 0; k < 2; ++k) dst[m][k] = *(const LAS bf16x8*)(lds + PG8_SA(b, h) + aoff + m * 2048 + k * 1024); } while (0)
#define PG8_LDB(dst, b, h) do { _Pragma("unroll") for (int n = 0; n < 2; ++n) _Pragma("unroll") for (int k = 0; k < 2; ++k) dst[n][k] = *(const LAS bf16x8*)(lds + PG8_SB(b, h) + boff + n * 2048 + k * 1024); } while (0)
#define PG8_MMA(ai, bj, At, Bt) do { __builtin_amdgcn_s_setprio(1); _Pragma("unroll") for (int m = 0; m < 4; ++m) _Pragma("unroll") for (int n = 0; n < 2; ++n) _Pragma("unroll") for (int k = 0; k < 2; ++k) \
        acc[ai][bj][m][n] = __builtin_amdgcn_mfma_f32_16x16x32_bf16(Bt[n][k], At[m][k], acc[ai][bj][m][n], 0, 0, 0); __builtin_amdgcn_s_setprio(0); } while (0)
#define PG8_WAIT_V(n) asm volatile("s_waitcnt vmcnt(" #n ")" ::: "memory")
#define PG8_WAIT_L(n) asm volatile("s_waitcnt lgkmcnt(" #n ")" ::: "memory")
#define PG8_BAR __builtin_amdgcn_s_barrier()
#define PG8_SCHED __builtin_amdgcn_sched_barrier(0)
    Unit cur, nxt; int ui = 0;
    if (!S.next(0, cur)) return;
#define PG8_DEPWAIT() do { unsigned _sp = 0; while ((unsigned)__builtin_amdgcn_readfirstlane((int)__hip_atomic_load(E.dep, __ATOMIC_RELAXED, __HIP_MEMORY_SCOPE_AGENT)) < 16u) { __builtin_amdgcn_s_sleep(4); if (++_sp > (1u << 18)) break; } \
        __builtin_amdgcn_fence(__ATOMIC_ACQUIRE, "agent"); asm volatile("s_waitcnt vmcnt(0)" ::: "memory"); } while (0)
    if (E.dep && cur.pm >= 64) PG8_DEPWAIT();
    f32x4 acc[2][2][4][2];
#pragma unroll
    for (int a = 0; a < 2; ++a)
#pragma unroll
        for (int b = 0; b < 2; ++b)
#pragma unroll
            for (int m = 0; m < 4; ++m)
#pragma unroll
                for (int n = 0; n < 2; ++n) acc[a][b][m][n] = (f32x4){0.f, 0.f, 0.f, 0.f};
    bf16x8 At[4][2], B0[2][2], B1[2][2];
    const char* cA = (const char*)g.A + (size_t)cur.pm * tstep; const char* cB = (const char*)g.Bt + (size_t)cur.pn * tstep;
    PG8_STAGE(PG8_SB(0, 0), cB, voffB); PG8_STAGE(PG8_SB(0, 1), cB + hstep, voffB); PG8_STAGE(PG8_SA(0, 0), cA, voffA); PG8_STAGE(PG8_SA(0, 1), cA + hstep, voffA);
    if (wr == 1) PG8_BAR;
    PG8_WAIT_V(2); PG8_BAR;
    PG8_STAGE(PG8_SB(1, 0), cB + kstep, voffB); PG8_STAGE(PG8_SA(1, 0), cA + kstep, voffA); PG8_STAGE(PG8_SB(1, 1), cB + hstep + kstep, voffB);
    PG8_WAIT_V(6); PG8_BAR;
    for (;;) {
        const bool has_next = S.next(ui + 1, nxt);
        if (E.dep && has_next && nxt.pm >= 64 && cur.pm < 64) PG8_DEPWAIT();
        const char* nA = has_next ? (const char*)g.A + (size_t)nxt.pm * tstep : cA; const char* nB = has_next ? (const char*)g.Bt + (size_t)nxt.pn * tstep : cB;
        for (int t = 0; t < nt; t += 2) {
            const bool last = (t == nt - 2);
            const char* a1 = cA + (size_t)(t + 1) * kstep;
            const char* a2 = last ? nA : cA + (size_t)(t + 2) * kstep; const char* b2 = last ? nB : cB + (size_t)(t + 2) * kstep;
            const char* a3 = a2 + kstep; const char* b3 = b2 + kstep;
            PG8_LDB(B0, 0, 0); PG8_LDB(B1, 0, 1); PG8_SCHED; PG8_LDA(At, 0, 0); PG8_STAGE(PG8_SA(1, 1), a1 + hstep, voffA);
            PG8_WAIT_V(8); PG8_WAIT_L(0); PG8_BAR; PG8_MMA(0, 0, At, B0); PG8_MMA(0, 1, At, B1); PG8_BAR; PG8_SCHED;
            PG8_LDA(At, 0, 1); PG8_STAGE(PG8_SB(0, 0), b2, voffB); PG8_STAGE(PG8_SB(0, 1), b2 + hstep, voffB); PG8_STAGE(PG8_SA(0, 0), a2, voffA);
            PG8_WAIT_V(8); PG8_WAIT_L(0); PG8_BAR; PG8_MMA(1, 0, At, B0); PG8_MMA(1, 1, At, B1); PG8_BAR; PG8_SCHED;
            PG8_LDB(B0, 1, 0); PG8_LDB(B1, 1, 1); PG8_SCHED; PG8_LDA(At, 1, 0); PG8_STAGE(PG8_SA(0, 1), a2 + hstep, voffA);
            PG8_WAIT_V(8); PG8_WAIT_L(0); PG8_BAR; PG8_MMA(0, 0, At, B0); PG8_MMA(0, 1, At, B1); PG8_BAR; PG8_SCHED;
            PG8_LDA(At, 1, 1); PG8_STAGE(PG8_SB(1, 0), b3, voffB); PG8_STAGE(PG8_SB(1, 1), b3 + hstep, voffB); PG8_STAGE(PG8_SA(1, 0), a3, voffA);
            PG8_WAIT_V(8); PG8_WAIT_L(0); PG8_BAR; PG8_MMA(1, 0, At, B0); PG8_MMA(1, 1, At, B1); PG8_BAR; PG8_SCHED;
        }
        if (wr == 0) PG8_BAR;
        epi_apply(p, E, acc, cur, wr, wc, fr, fq);
        if (!has_next) break;
#pragma unroll
        for (int a = 0; a < 2; ++a)
#pragma unroll
            for (int b = 0; b < 2; ++b)
#pragma unroll
                for (int m = 0; m < 4; ++m)
#pragma unroll
                    for (int n = 0; n < 2; ++n) acc[a][b][m][n] = (f32x4){0.f, 0.f, 0.f, 0.f};
        cur = nxt; cA = nA; cB = nB; ++ui;
        if (wr == 1) PG8_BAR;
    }
    PG8_WAIT_V(0);
    PG8_BAR;
#undef PG8_DEPWAIT
#undef PG8_SA
#undef PG8_SB
#undef PG8_STAGE
#undef PG8_LDA
#undef PG8_LDB
#undef PG8_MMA
#undef PG8_WAIT_V
#undef PG8_WAIT_L
#undef PG8_BAR
#undef PG8_SCHED
}

struct TileJob { const float* src; bf16_t* dst; const float* gk; int ld, dstK, k0, n0, dr0; };
__device__ __forceinline__ TileJob decode_tile(const Params& p, int t) {
    TileJob j; int nN, tt, job;
    if (t < 576) { job = 0; tt = t; j.src = p.w_in; j.ld = INW; nN = 36; j.dst = (bf16_t*)(p.ws + WS_WIN); j.dstK = 1024; }
    else if (t < 640) { job = 3; tt = t - 576; j.src = p.w_ck; j.ld = 256; nN = 4; j.dst = (bf16_t*)(p.ws + WS_WCKV); j.dstK = 1024; }
    else if (t < 704) { job = 4; tt = t - 640; j.src = p.w_cv; j.ld = 256; nN = 4; j.dst = (bf16_t*)(p.ws + WS_WCKV); j.dstK = 1024; }
    else if (t < 960) { job = 1; tt = t - 704; j.src = p.w_out; j.ld = 1024; nN = 16; j.dst = (bf16_t*)(p.ws + WS_WOUT); j.dstK = 1024; }
    else if (t < 1024) { job = 2; tt = t - 960; j.src = p.w_cq; j.ld = 256; nN = 4; j.dst = (bf16_t*)(p.ws + WS_WCQ); j.dstK = 1024; }
    else if (t < 1088) { job = 5; tt = t - 1024; j.src = p.w_co; j.ld = 1024; nN = 16; j.dst = (bf16_t*)(p.ws + WS_WCO); j.dstK = 256; }
    else if (t < 1792) { job = 6; tt = t - 1088; j.src = p.w_gate; j.ld = FFN; nN = 44; j.dst = (bf16_t*)(p.ws + WS_WGU); j.dstK = 1024; }
    else if (t < 2496) { job = 7; tt = t - 1792; j.src = p.w_up; j.ld = FFN; nN = 44; j.dst = (bf16_t*)(p.ws + WS_WGU); j.dstK = 1024; }
    else { job = 8; tt = t - 2496; j.src = p.w_down; j.ld = 1024; nN = 16; j.dst = (bf16_t*)(p.ws + WS_WD); j.dstK = FFN; }
    const int kt = tt / nN, ntile = tt % nN; j.n0 = ntile * 64; j.k0 = kt * 64;
    j.dr0 = j.n0;
    if (job == 4) j.dr0 = 256 + j.n0;
    else if (job == 6) j.dr0 = (j.n0 >> 7) * 256 + (j.n0 & 127);
    else if (job == 7) j.dr0 = (j.n0 >> 7) * 256 + 128 + (j.n0 & 127);
    j.gk = (job == 2) ? p.g_cross : ((job == 6 || job == 7) ? p.g_ffn : nullptr);
    return j;
}
constexpr int TILE_F = 64 * 65;
__device__ __forceinline__ void conv_tiles(const Params& p, unsigned char* shm, int t_lo, int t_hi, int w, int nw) {
    const int tid = opaque_tid();
    float* tiles = (float*)shm;
    for (int t0 = t_lo + 4 * w; t0 < t_hi; t0 += 4 * nw) {
#pragma unroll
        for (int q = 0; q < 4; ++q) {
            if (t0 + q < t_hi) { const TileJob j = decode_tile(p, t0 + q); float* tile = tiles + q * TILE_F;
#pragma unroll
                for (int i = 0; i < 8; ++i) { const int kl = (tid >> 6) + 8 * i, nl = tid & 63; const float gs = j.gk ? j.gk[j.k0 + kl] : 1.0f; tile[kl * 65 + nl] = j.src[(size_t)(j.k0 + kl) * j.ld + j.n0 + nl] * gs; } }
        }
        __syncthreads();
#pragma unroll
        for (int q = 0; q < 4; ++q) {
            if (t0 + q < t_hi) { const TileJob j = decode_tile(p, t0 + q); const float* tile = tiles + q * TILE_F;
                const int nl = tid >> 3, kc = tid & 7; float v[8];
#pragma unroll
                for (int jj = 0; jj < 8; ++jj) v[jj] = tile[(kc * 8 + jj) * 65 + nl];
                u32x4 o; o[0] = pk_bf16(v[0], v[1]); o[1] = pk_bf16(v[2], v[3]); o[2] = pk_bf16(v[4], v[5]); o[3] = pk_bf16(v[6], v[7]);
                *(u32x4*)(j.dst + (size_t)(j.dr0 + nl) * j.dstK + j.k0 + kc * 8) = o; }
        }
        __syncthreads();
    }
}
constexpr int T_EARLY = 704, T_MID = 1024, T_ALL = 3200;

__device__ __forceinline__ void phase0(const Params& p, unsigned char* shm, bool all_tiles) {
    const int tid = opaque_tid(), lane = tid & 63, wid = tid >> 6;
    float* wgT = (float*)(shm + 4 * TILE_F * 4);
    for (int idx = tid; idx < 8192; idx += NTHREADS) { const int k = idx >> 3, j = idx & 7; wgT[j * 1024 + k] = p.w_in[(size_t)k * INW + ZW + j]; }
    __syncthreads();
    {
        bf16_t* XN = (bf16_t*)(p.ws + WS_XN); bf16_t* MN = (bf16_t*)(p.ws + WS_MN); float* GT = (float*)(p.ws + WS_GATES);
        for (int rp = blockIdx.x * 8 + wid; rp < (M + 1024) / 2; rp += gridDim.x * 8) {
            const int row0 = 2 * rp;
            const bool ismem = row0 >= M;
            const float* gg = ismem ? p.g_mem : p.g_mix;
            f32x4 v[2][4]; float ss[2];
#pragma unroll
            for (int q = 0; q < 2; ++q) { const int row = row0 + q; const float* src = ismem ? p.mem_prompt + (size_t)(row - M) * D : xrow(p, row);
#pragma unroll
                for (int i = 0; i < 4; ++i) v[q][i] = __builtin_nontemporal_load((const f32x4*)(src + 4 * (lane + 64 * i))); }
            f32x4 gv[4];
#pragma unroll
            for (int i = 0; i < 4; ++i) gv[i] = *(const f32x4*)(gg + 4 * (lane + 64 * i));
#pragma unroll
            for (int q = 0; q < 2; ++q) { float s = 0.f;
#pragma unroll
                for (int i = 0; i < 4; ++i) s += v[q][i][0] * v[q][i][0] + v[q][i][1] * v[q][i][1] + v[q][i][2] * v[q][i][2] + v[q][i][3] * v[q][i][3];
                ss[q] = wave_sum(s); }
#pragma unroll
            for (int q = 0; q < 2; ++q) {
                const int row = row0 + q;
                const float rstd = rsqrtf(ss[q] * (1.0f / D) + 1e-6f);
                bf16_t* dst = ismem ? MN + (size_t)(row - M) * D : XN + (size_t)row * D;
#pragma unroll
                for (int i = 0; i < 4; ++i) { v[q][i] = v[q][i] * rstd * gv[i];
                    u32x2 o; o[0] = pk_bf16(v[q][i][0], v[q][i][1]); o[1] = pk_bf16(v[q][i][2], v[q][i][3]); *(u32x2*)(dst + 4 * (lane + 64 * i)) = o; }
            }
            if (!ismem) {
#pragma unroll
                for (int q = 0; q < 2; ++q) {
                    float a8[8];
#pragma unroll
                    for (int j = 0; j < 8; ++j) { float a = 0.f;
#pragma unroll
                        for (int i = 0; i < 4; ++i) { const f32x4 w = *(const f32x4*)(wgT + j * 1024 + 4 * (lane + 64 * i)); a += v[q][i][0] * w[0] + v[q][i][1] * w[1] + v[q][i][2] * w[2] + v[q][i][3] * w[3]; }
                        a8[j] = a; }
                    const bool h5 = lane & 32, h4 = lane & 16, h3 = lane & 8;
                    float b4[4], c2[2];
#pragma unroll
                    for (int j = 0; j < 4; ++j) { const float snd = h5 ? a8[j] : a8[j + 4]; const float rcv = __shfl_xor(snd, 32); b4[j] = (h5 ? a8[j + 4] : a8[j]) + rcv; }
#pragma unroll
                    for (int j = 0; j < 2; ++j) { const float snd = h4 ? b4[j] : b4[j + 2]; const float rcv = __shfl_xor(snd, 16); c2[j] = (h4 ? b4[j + 2] : b4[j]) + rcv; }
                    float z;
                    { const float snd = h3 ? c2[0] : c2[1]; const float rcv = __shfl_xor(snd, 8); z = (h3 ? c2[1] : c2[0]) + rcv; }
                    z += __shfl_xor(z, 4); z += __shfl_xor(z, 2); z += __shfl_xor(z, 1);
                    if ((lane & 7) == 0) {
                        const int gidx = lane >> 3;
                        float o;
                        if (gidx < 4) o = z + p.b_ig[gidx];
                        else { const float xx = z + p.b_fg[gidx - 4]; o = fminf(xx, 0.f) - log1pf(__expf(-fabsf(xx))); }
                        GT[(size_t)(row0 + q) * 8 + gidx] = o;
                    }
                }
            }
        }
    }
    __syncthreads();
    conv_tiles(p, shm, 0, all_tiles ? T_ALL : T_EARLY, blockIdx.x, gridDim.x);
}

constexpr int KSTR = 72;
template <class MaskF, class FullF>
__device__ __forceinline__ void attn_tiles(const bf16_t* Ks, const bf16_t* Vt, int vstr, const bf16x8 (&Qf)[4], int t0, int t1, float scale_log2, const MaskF& mask, const FullF& full,
                                           f32x16& O0, f32x16& O1, float& m_run, float& l_run) {
    const int lane = threadIdx.x & 63, r = lane & 31, h = lane >> 5;
    for (int t = t0; t < t1; ++t) {
        f32x16 S;
#pragma unroll
        for (int i = 0; i < 16; ++i) S[i] = 0.f;
#pragma unroll
        for (int s = 0; s < 4; ++s) {
            const bf16x8 a = *(const bf16x8*)(Ks + (t * 32 + r) * KSTR + 16 * s + 8 * h);
            __builtin_amdgcn_s_setprio(1);
            S = __builtin_amdgcn_mfma_f32_32x32x16_bf16(a, Qf[s], S, 0, 0, 0);
            __builtin_amdgcn_s_setprio(0);
        }
        float mx = -INFINITY;
        if (full(t)) {
#pragma unroll
            for (int i = 0; i < 16; ++i) mx = fmaxf(mx, S[i]);
        } else {
#pragma unroll
            for (int i = 0; i < 16; ++i) { const int kk = t * 32 + (i & 3) + 8 * (i >> 2) + 4 * h; const float v = mask(kk) ? S[i] : -INFINITY; S[i] = v; mx = fmaxf(mx, v); }
        }
        mx = fmaxf(mx, __shfl_xor(mx, 32));
        const float mn = fmaxf(m_run, mx * scale_log2);
        if (__builtin_amdgcn_ballot_w64(mn != m_run) != 0ull) {
            const float alpha = __builtin_amdgcn_exp2f(m_run - mn);
            l_run *= alpha; m_run = mn;
#pragma unroll
            for (int i = 0; i < 16; ++i) { O0[i] *= alpha; O1[i] *= alpha; }
        }
        float rs = 0.f;
#pragma unroll
        for (int i = 0; i < 16; ++i) { const float pp = __builtin_amdgcn_exp2f(__builtin_fmaf(S[i], scale_log2, -mn)); S[i] = pp; rs += pp; }
        rs += __shfl_xor(rs, 32);
        l_run += rs;
#pragma unroll
        for (int s2 = 0; s2 < 2; ++s2) {
            u32x4 pbu; pbu[0] = pk_bf16(S[8 * s2 + 0], S[8 * s2 + 1]); pbu[1] = pk_bf16(S[8 * s2 + 2], S[8 * s2 + 3]); pbu[2] = pk_bf16(S[8 * s2 + 4], S[8 * s2 + 5]); pbu[3] = pk_bf16(S[8 * s2 + 6], S[8 * s2 + 7]);
            const bf16x8 pb = __builtin_bit_cast(bf16x8, pbu);
            {
                const bf16_t* vp = Vt + (size_t)r * vstr + t * 32 + 16 * s2 + 4 * h;
                u32x4 au; const u32x2 lo = *(const u32x2*)vp, hi = *(const u32x2*)(vp + 8); au[0] = lo[0]; au[1] = lo[1]; au[2] = hi[0]; au[3] = hi[1];
                O0 = __builtin_amdgcn_mfma_f32_32x32x16_bf16(__builtin_bit_cast(bf16x8, au), pb, O0, 0, 0, 0);
            }
            {
                const bf16_t* vp = Vt + (size_t)(32 + r) * vstr + t * 32 + 16 * s2 + 4 * h;
                u32x4 au; const u32x2 lo = *(const u32x2*)vp, hi = *(const u32x2*)(vp + 8); au[0] = lo[0]; au[1] = lo[1]; au[2] = hi[0]; au[3] = hi[1];
                O1 = __builtin_amdgcn_mfma_f32_32x32x16_bf16(__builtin_bit_cast(bf16x8, au), pb, O1, 0, 0, 0);
            }
        }
    }
}
__device__ __forceinline__ void attn_store(bf16_t* dst, const f32x16& O0, const f32x16& O1, float l_run, int h) {
    const float inv = 1.0f / l_run;
#pragma unroll
    for (int g = 0; g < 4; ++g) {
        u32x2 o; o[0] = pk_bf16(O0[4 * g] * inv, O0[4 * g + 1] * inv); o[1] = pk_bf16(O0[4 * g + 2] * inv, O0[4 * g + 3] * inv);
        *(u32x2*)(dst + 8 * g + 4 * h) = o;
        u32x2 o1; o1[0] = pk_bf16(O1[4 * g] * inv, O1[4 * g + 1] * inv); o1[1] = pk_bf16(O1[4 * g + 2] * inv, O1[4 * g + 3] * inv);
        *(u32x2*)(dst + 32 + 8 * g + 4 * h) = o1;
    }
}
constexpr float SCALE_LOG2 = 0.125f * 1.4426950408889634f;
constexpr float LOG2E = 1.4426950408889634f;

__device__ __forceinline__ void swa_prompt_unit(const Params& p, unsigned char* shm, int unit) {
    const int tid = opaque_tid(), lane = tid & 63, wid = tid >> 6, r = lane & 31, h = lane >> 5;
    const int n = unit & 31, kvh = (unit >> 5) & 1, b = unit >> 6;
    const int start = n * 128;
    const bf16_t* Z = (const bf16_t*)(p.ws + WS_Z);
    bf16_t* CAT = (bf16_t*)(p.ws + WS_CAT);
    bf16_t* Ks = (bf16_t*)shm;
    bf16_t* Vt = (bf16_t*)(shm + 256 * KSTR * 2);
    constexpr int VSTR = 264;
#pragma unroll
    for (int i = 0; i < 4; ++i) {
        const int idx = tid + 512 * i, key = idx >> 3, ch = idx & 7;
        const int tok = start - 128 + key;
        u32x4 kq = {0u, 0u, 0u, 0u}, vq = {0u, 0u, 0u, 0u};
        if (tok >= 0) { const bf16_t* zr = Z + (size_t)(b * SEQ + tok) * ZW + kvh * 64 + ch * 8; kq = *(const u32x4*)(zr + ZK); vq = *(const u32x4*)(zr + ZV); }
        *(u32x4*)(Ks + key * KSTR + ch * 8) = kq;
#pragma unroll
        for (int j = 0; j < 4; ++j) { Vt[(ch * 8 + 2 * j) * VSTR + key] = (bf16_t)(vq[j] & 0xffffu); Vt[(ch * 8 + 2 * j + 1) * VSTR + key] = (bf16_t)(vq[j] >> 16); }
    }
    __syncthreads();
    const int g = wid >> 1, half = wid & 1, head = kvh * 4 + g;
    const float sink = p.sinks[head] * LOG2E;
    for (int qb = 0; qb < 2; ++qb) {
        const int i0 = half * 64 + qb * 32, qi = i0 + r;
        const int row = b * SEQ + start + qi;
        bf16x8 Qf[4];
#pragma unroll
        for (int s = 0; s < 4; ++s) Qf[s] = *(const bf16x8*)(Z + (size_t)row * ZW + ZQ + head * 64 + 16 * s + 8 * h);
        f32x16 O0, O1;
#pragma unroll
        for (int i = 0; i < 16; ++i) { O0[i] = 0.f; O1[i] = 0.f; }
        float m_run = sink, l_run = 1.0f;
        const int kmin = (start == 0) ? 128 : 0;
        auto mask = [=](int kk) { return kk >= qi && kk <= qi + 128 && kk >= kmin; };
        const int tb = i0 >> 5;
        auto full = [=](int t) { return t > tb && t < tb + 4 && 32 * t >= kmin; };
        attn_tiles(Ks, Vt, VSTR, Qf, tb, tb + 5, SCALE_LOG2, mask, full, O0, O1, m_run, l_run);
        attn_store(CAT + (size_t)row * D + head * 64, O0, O1, l_run, h);
    }
    __syncthreads();
}

__device__ __forceinline__ void swa_sample_unit(const Params& p, unsigned char* shm, int b) {
    const int tid = opaque_tid(), lane = tid & 63, wid = tid >> 6, r = lane & 31, h = lane >> 5;
    const bf16_t* Z = (const bf16_t*)(p.ws + WS_Z);
    bf16_t* CAT = (bf16_t*)(p.ws + WS_CAT);
    constexpr int VSTR = 168, KIMG = 160 * KSTR, VIMG = 64 * VSTR;
    bf16_t* Ks = (bf16_t*)shm;
    bf16_t* Vt = (bf16_t*)(shm + 2 * KIMG * 2);
    float* outk = p.out + O_SKS + (size_t)b * 16384; float* outv = p.out + O_SVS + (size_t)b * 16384;
    const float* ck = p.cache_swa_k + (size_t)b * 16384; const float* cv = p.cache_swa_v + (size_t)b * 16384;
    for (int idx = tid; idx < 2 * 24 * KSTR; idx += NTHREADS) { const int kv = idx / (24 * KSTR), rem = idx % (24 * KSTR); Ks[kv * KIMG + 136 * KSTR + rem] = 0; }
    for (int idx = tid; idx < 2 * 64 * 24; idx += NTHREADS) { const int kv = idx / (64 * 24), rem = idx % (64 * 24), d = rem / 24, kk = rem % 24; Vt[kv * VIMG + d * VSTR + 136 + kk] = 0; }
#pragma unroll
    for (int i = 0; i < 8; ++i) {
        const int idx = tid + 512 * i, j = idx >> 5, c4 = idx & 31, kvh = c4 >> 4, d = (c4 & 15) * 4;
        const f32x4 kq = __builtin_nontemporal_load((const f32x4*)(ck + j * 128 + c4 * 4)), vq = __builtin_nontemporal_load((const f32x4*)(cv + j * 128 + c4 * 4));
        u32x2 o; o[0] = pk_bf16(kq[0], kq[1]); o[1] = pk_bf16(kq[2], kq[3]);
        *(u32x2*)(Ks + kvh * KIMG + j * KSTR + d) = o;
        const unsigned v01 = pk_bf16(vq[0], vq[1]), v23 = pk_bf16(vq[2], vq[3]);
        bf16_t* vb = Vt + kvh * VIMG + d * VSTR + j;
        vb[0] = (bf16_t)(v01 & 0xffffu); vb[VSTR] = (bf16_t)(v01 >> 16); vb[2 * VSTR] = (bf16_t)(v23 & 0xffffu); vb[3 * VSTR] = (bf16_t)(v23 >> 16);
        if (j >= 8) { *(f32x4*)(outk + (j - 8) * 128 + c4 * 4) = kq; *(f32x4*)(outv + (j - 8) * 128 + c4 * 4) = vq; }
    }
    {
        const int e = tid * 2, t = e >> 7, col = e & 127, kvh = col >> 6, d = col & 63;
        const bf16_t* zr = Z + (size_t)(MP + b * 8 + t) * ZW;
        const unsigned kq = *(const unsigned*)(zr + ZK + col), vq = *(const unsigned*)(zr + ZV + col);
        *(unsigned*)(Ks + kvh * KIMG + (128 + t) * KSTR + d) = kq;
        Vt[kvh * VIMG + d * VSTR + 128 + t] = (bf16_t)(vq & 0xffffu); Vt[kvh * VIMG + (d + 1) * VSTR + 128 + t] = (bf16_t)(vq >> 16);
        outk[(120 + t) * 128 + col] = bf_lo(kq); outk[(120 + t) * 128 + col + 1] = bf_hi(kq);
        outv[(120 + t) * 128 + col] = bf_lo(vq); outv[(120 + t) * 128 + col + 1] = bf_hi(vq);
    }
    __syncthreads();
    if (wid < 2) {
        const int kvh = wid, g = r >> 3, t = r & 7, head = kvh * 4 + g;
        const int row = MP + b * 8 + t;
        bf16x8 Qf[4];
#pragma unroll
        for (int s = 0; s < 4; ++s) Qf[s] = *(const bf16x8*)(Z + (size_t)row * ZW + ZQ + head * 64 + 16 * s + 8 * h);
        f32x16 O0, O1;
#pragma unroll
        for (int i = 0; i < 16; ++i) { O0[i] = 0.f; O1[i] = 0.f; }
        float m_run = p.sinks[head] * LOG2E, l_run = 1.0f;
        auto mask = [=](int kk) { return kk >= t && kk <= t + 128; };
        auto full = [=](int tt) { return tt >= 1 && tt <= 3; };
        attn_tiles(Ks + kvh * KIMG, Vt + kvh * VIMG, VSTR, Qf, 0, 5, SCALE_LOG2, mask, full, O0, O1, m_run, l_run);
        attn_store(CAT + (size_t)row * D + head * 64, O0, O1, l_run, h);
    }
    __syncthreads();
}

__device__ __forceinline__ void cross_prompt_unit(const Params& p, unsigned char* shm, int unit) {
    const int tid = opaque_tid(), lane = tid & 63, wid = tid >> 6, r = lane & 31, h = lane >> 5;
    const int qt = unit & 15, head = (unit >> 4) & 3, b = unit >> 6;
    const bf16_t* MKV = (const bf16_t*)(p.ws + WS_MEMKV);
    const bf16_t* Q2 = (const bf16_t*)(p.ws + WS_Q2);
    bf16_t* O2 = (bf16_t*)(p.ws + WS_O2);
    bf16_t* Ks = (bf16_t*)shm; bf16_t* Vt = (bf16_t*)(shm + 256 * KSTR * 2);
    constexpr int VSTR = 264;
#pragma unroll
    for (int i = 0; i < 4; ++i) {
        const int idx = tid + 512 * i, key = idx >> 3, ch = idx & 7;
        const bf16_t* mr = MKV + (size_t)(b * 256 + key) * 512 + head * 64 + ch * 8;
        const u32x4 kq = *(const u32x4*)mr, vq = *(const u32x4*)(mr + 256);
        *(u32x4*)(Ks + key * KSTR + ch * 8) = kq;
#pragma unroll
        for (int j = 0; j < 4; ++j) { Vt[(ch * 8 + 2 * j) * VSTR + key] = (bf16_t)(vq[j] & 0xffffu); Vt[(ch * 8 + 2 * j + 1) * VSTR + key] = (bf16_t)(vq[j] >> 16); }
    }
    __syncthreads();
    const int row = b * SEQ + qt * 256 + wid * 32 + r;
    bf16x8 Qf[4];
#pragma unroll
    for (int s = 0; s < 4; ++s) Qf[s] = *(const bf16x8*)(Q2 + (size_t)row * 256 + head * 64 + 16 * s + 8 * h);
    f32x16 O0, O1;
#pragma unroll
    for (int i = 0; i < 16; ++i) { O0[i] = 0.f; O1[i] = 0.f; }
    float m_run = -1e30f, l_run = 0.f;
    auto mask = [=](int) { return true; };
    attn_tiles(Ks, Vt, VSTR, Qf, 0, 8, SCALE_LOG2, mask, mask, O0, O1, m_run, l_run);
    attn_store(O2 + (size_t)row * 256 + head * 64, O0, O1, l_run, h);
    __syncthreads();
}
__device__ __forceinline__ void cross_sample_unit(const Params& p, unsigned char* shm, int unit) {
    const int tid = opaque_tid(), lane = tid & 63, wid = tid >> 6, r = lane & 31, h = lane >> 5;
    const int head = unit & 3, b = unit >> 2;
    const bf16_t* Q2 = (const bf16_t*)(p.ws + WS_Q2);
    bf16_t* O2 = (bf16_t*)(p.ws + WS_O2);
    bf16_t* Ks = (bf16_t*)shm; bf16_t* Vt = (bf16_t*)(shm + 256 * KSTR * 2);
    constexpr int VSTR = 264;
#pragma unroll
    for (int i = 0; i < 8; ++i) {
        const int idx = tid + 512 * i, key = idx >> 4, c4 = idx & 15, d = c4 * 4;
        const size_t off = ((size_t)(b * 256 + key) * 4 + head) * 64 + d;
        const f32x4 kq = __builtin_nontemporal_load((const f32x4*)(p.cache_mem_k + off)), vq = __builtin_nontemporal_load((const f32x4*)(p.cache_mem_v + off));
        u32x2 o; o[0] = pk_bf16(kq[0], kq[1]); o[1] = pk_bf16(kq[2], kq[3]);
        *(u32x2*)(Ks + key * KSTR + d) = o;
        const unsigned v01 = pk_bf16(vq[0], vq[1]), v23 = pk_bf16(vq[2], vq[3]);
        bf16_t* vb = Vt + d * VSTR + key;
        vb[0] = (bf16_t)(v01 & 0xffffu); vb[VSTR] = (bf16_t)(v01 >> 16); vb[2 * VSTR] = (bf16_t)(v23 & 0xffffu); vb[3 * VSTR] = (bf16_t)(v23 >> 16);
    }
    __syncthreads();
    if (wid == 0) {
        const int t = r & 7, row = MP + b * 8 + t;
        bf16x8 Qf[4];
#pragma unroll
        for (int s = 0; s < 4; ++s) Qf[s] = *(const bf16x8*)(Q2 + (size_t)row * 256 + head * 64 + 16 * s + 8 * h);
        f32x16 O0, O1;
#pragma unroll
        for (int i = 0; i < 16; ++i) { O0[i] = 0.f; O1[i] = 0.f; }
        float m_run = -1e30f, l_run = 0.f;
        auto mask = [=](int) { return true; };
        attn_tiles(Ks, Vt, VSTR, Qf, 0, 8, SCALE_LOG2, mask, mask, O0, O1, m_run, l_run);
        if (r < 8) attn_store(O2 + (size_t)row * 256 + head * 64, O0, O1, l_run, h);
    }
    __syncthreads();
}

__device__ __forceinline__ void unpack8(const u32x4 q, float* v) {
#pragma unroll
    for (int j = 0; j < 4; ++j) { v[2 * j] = bf_lo(q[j]); v[2 * j + 1] = bf_hi(q[j]); }
}
__device__ __forceinline__ void mlstm_scan(const Params& p) {
    const float* SC = (const float*)(p.ws + WS_SCAL); float* MPV = (float*)(p.ws + WS_SCAL) + 2048;
    const bf16_t* UT = (const bf16_t*)(p.ws + WS_UT); const float* NT = (const float*)(p.ws + WS_NT);
    bf16_t* CPREV = (bf16_t*)(p.ws + WS_CPREV); float* NPREV = (float*)(p.ws + WS_NPREV);
    const int tid = opaque_tid();
    for (int base = blockIdx.x * NTHREADS; base < 16 * 8192; base += gridDim.x * NTHREADS) {
        const int bh = base >> 13, elem = (base & 8191) + tid;
        const bool doN = elem < 64;
        float m = 0.f, C = 0.f, n = 0.f;
#pragma unroll 1
        for (int hf = 0; hf < 2; ++hf) {
            const int u0 = bh * 64 + hf * 32;
            float u[32], nn[32];
#pragma unroll
            for (int j = 0; j < 32; ++j) u[j] = bf2f(UT[(size_t)(u0 + j) * 8192 + elem]);
            if (doN) {
#pragma unroll
                for (int j = 0; j < 32; ++j) nn[j] = NT[(u0 + j) * 64 + elem];
            } else {
#pragma unroll
                for (int j = 0; j < 32; ++j) nn[j] = 0.f;
            }
#pragma unroll
            for (int j = 0; j < 32; ++j) {
                const int unit = u0 + j;
                const float A = SC[unit], bL = SC[1024 + unit];
                CPREV[(size_t)unit * 8192 + elem] = (bf16_t)(pk_bf16(C, C) & 0xffffu);
                if (doN) NPREV[unit * 64 + elem] = n;
                if (elem == 0) MPV[unit] = m;
                const float mn = bL + fmaxf(A, m);
                const float wc = __expf(bL + m - mn), g = __expf(A + bL - mn);
                C = wc * C + g * u[j];
                n = wc * n + g * nn[j];
                m = mn;
            }
        }
        p.out[O_CP + (size_t)bh * 8192 + elem] = C;
        if (doN) p.out[O_NP + bh * 64 + elem] = n;
        if (elem == 0) p.out[O_MP + bh] = m;
    }
}

constexpr int MVS = 72;
constexpr int ML_SLOT = 128 * MVS * 2 + 64 * MVS * 2 + 256;
__device__ __forceinline__ void mlstm_local_group(const Params& p, unsigned char* shm, int grp) {
    const int tid = opaque_tid(), lane = tid & 63, wid = tid >> 6, slot = wid >> 1, wq = wid & 1, r = lane & 31, hl = lane >> 5;
    const int unit = grp * 4 + slot, bh = unit >> 6, c = unit & 63, b = bh >> 2, hh = bh & 3;
    const int row0 = b * SEQ + c * 64;
    const bf16_t* Z = (const bf16_t*)(p.ws + WS_Z);
    const float* GT = (const float*)(p.ws + WS_GATES);
    float* SC = (float*)(p.ws + WS_SCAL);
    bf16_t* UT = (bf16_t*)(p.ws + WS_UT); float* NT = (float*)(p.ws + WS_NT);
    bf16_t* Vt = (bf16_t*)(shm + slot * ML_SLOT);
    bf16_t* Kt = Vt + 128 * MVS;
    float* sW = (float*)(Kt + 64 * MVS);
    const float lf = GT[(size_t)(row0 + lane) * 8 + 4 + hh], ig = GT[(size_t)(row0 + lane) * 8 + hh];
    const float bt = wave_scan_add(lf, lane);
    const float a = ig - bt;
    const float A = wave_max(a);
    const float wt = __expf(a - A);
    if (wq == 0) { sW[lane] = wt; if (lane == 63) SC[1024 + unit] = bt; if (lane == 0) SC[unit] = A; }
    const bf16_t* zr = Z + (size_t)(row0 + lane) * ZW;
#pragma unroll
    for (int i = 0; i < 8; ++i) { const int ch = wq + 2 * i; float v[8];
        unpack8(*(const u32x4*)(zr + ZMV + hh * 128 + ch * 8), v);
#pragma unroll
        for (int j = 0; j < 8; j += 2) { const unsigned pk = pk_bf16(v[j] * wt, v[j + 1] * wt); Vt[(ch * 8 + j) * MVS + lane] = (bf16_t)(pk & 0xffffu); Vt[(ch * 8 + j + 1) * MVS + lane] = (bf16_t)(pk >> 16); } }
#pragma unroll
    for (int i = 0; i < 4; ++i) { const int ch = wq + 2 * i; float v[8];
        unpack8(*(const u32x4*)(zr + ZMK + hh * 64 + ch * 8), v);
#pragma unroll
        for (int j = 0; j < 8; j += 2) { const unsigned pk = pk_bf16(v[j] * 0.125f, v[j + 1] * 0.125f); Kt[(ch * 8 + j) * MVS + lane] = (bf16_t)(pk & 0xffffu); Kt[(ch * 8 + j + 1) * MVS + lane] = (bf16_t)(pk >> 16); } }
    __syncthreads();
    f32x16 acc[2][2];
#pragma unroll
    for (int e = 0; e < 2; ++e)
#pragma unroll
        for (int d = 0; d < 2; ++d)
#pragma unroll
            for (int i = 0; i < 16; ++i) acc[e][d][i] = 0.f;
#pragma unroll
    for (int ks = 0; ks < 4; ++ks) {
        bf16x8 Af[2], Bf[2];
#pragma unroll
        for (int e = 0; e < 2; ++e) Af[e] = *(const bf16x8*)(Vt + (32 * (2 * wq + e) + r) * MVS + 16 * ks + 8 * hl);
#pragma unroll
        for (int d = 0; d < 2; ++d) Bf[d] = *(const bf16x8*)(Kt + (32 * d + r) * MVS + 16 * ks + 8 * hl);
#pragma unroll
        for (int e = 0; e < 2; ++e)
#pragma unroll
            for (int d = 0; d < 2; ++d) acc[e][d] = __builtin_amdgcn_mfma_f32_32x32x16_bf16(Af[e], Bf[d], acc[e][d], 0, 0, 0);
    }
#pragma unroll
    for (int e = 0; e < 2; ++e)
#pragma unroll
        for (int d = 0; d < 2; ++d)
#pragma unroll
            for (int i = 0; i < 16; ++i) { const int ee = 32 * (2 * wq + e) + (i & 3) + 8 * (i >> 2) + 4 * hl;
                UT[(size_t)unit * 8192 + ee * 64 + 32 * d + r] = (bf16_t)(pk_bf16(acc[e][d][i], acc[e][d][i]) & 0xffffu); }
    if (wq == 1) { float nn = 0.f;
#pragma unroll 8
        for (int s = 0; s < 64; ++s) nn += sW[s] * bf2f(Kt[lane * MVS + s]);
        NT[(size_t)unit * 64 + lane] = nn; }
    __syncthreads();
}
__device__ __forceinline__ void mlstm_out_group(const Params& p, unsigned char* shm, int grp) {
    const int tid = opaque_tid(), lane = tid & 63, wid = tid >> 6, slot = wid >> 1, qb = wid & 1, r = lane & 31, hl = lane >> 5;
    const int unit = grp * 4 + slot, bh = unit >> 6, c = unit & 63, b = bh >> 2, hh = bh & 3;
    const int row0 = b * SEQ + c * 64;
    const bf16_t* Z = (const bf16_t*)(p.ws + WS_Z);
    const float* GT = (const float*)(p.ws + WS_GATES);
    const float* MPV = (const float*)(p.ws + WS_SCAL) + 2048;
    const bf16_t* CPREV = (const bf16_t*)(p.ws + WS_CPREV) + (size_t)unit * 8192; const float* NPREV = (const float*)(p.ws + WS_NPREV) + unit * 64;
    bf16_t* CAT = (bf16_t*)(p.ws + WS_CAT);
    bf16_t* Vt = (bf16_t*)(shm + slot * ML_SLOT);
    float* sA = (float*)(Vt + 128 * MVS + 64 * MVS);
    const float lf = GT[(size_t)(row0 + lane) * 8 + 4 + hh], ig = GT[(size_t)(row0 + lane) * 8 + hh];
    const float bt = wave_scan_add(lf, lane);
    const float a = ig - bt;
    const float cm = wave_scan_max(a, lane);
    const float mprev = MPV[unit];
    const float mt = bt + fmaxf(cm, mprev);
    const float wi = __expf(bt + mprev - mt);
    if (qb == 0) sA[lane] = a;
    u32x4 ogr[8];
    { const int tp = qb * 64 + lane;
#pragma unroll
      for (int i = 0; i < 8; ++i) { const int idx = tp + 128 * i, orow = idx >> 4, oc = idx & 15; ogr[i] = *(const u32x4*)(Z + (size_t)(row0 + orow) * ZW + ZOG + hh * 128 + oc * 8); } }
    const int l = 32 * qb + r;
    const float bt_l = __shfl(bt, l), mt_l = __shfl(mt, l), wi_l = __shfl(wi, l);
    { const bf16_t* zr = Z + (size_t)(row0 + lane) * ZW + ZMV + hh * 128;
#pragma unroll
      for (int i = 0; i < 8; ++i) { const int ch = qb + 2 * i; const u32x4 q = *(const u32x4*)(zr + ch * 8);
#pragma unroll
          for (int j = 0; j < 4; ++j) { Vt[(ch * 8 + 2 * j) * MVS + lane] = (bf16_t)(q[j] & 0xffffu); Vt[(ch * 8 + 2 * j + 1) * MVS + lane] = (bf16_t)(q[j] >> 16); } } }
    bf16x8 Qf[4]; float qn = 0.f;
#pragma unroll
    for (int ks = 0; ks < 4; ++ks) {
        const u32x4 qq = *(const u32x4*)(Z + (size_t)(row0 + l) * ZW + ZMQ + hh * 64 + 16 * ks + 8 * hl);
        Qf[ks] = __builtin_bit_cast(bf16x8, qq);
        float qv[8]; unpack8(qq, qv);
        const f32x4 n0 = *(const f32x4*)(NPREV + 16 * ks + 8 * hl), n1 = *(const f32x4*)(NPREV + 16 * ks + 8 * hl + 4);
        qn += qv[0] * n0[0] + qv[1] * n0[1] + qv[2] * n0[2] + qv[3] * n0[3] + qv[4] * n1[0] + qv[5] * n1[1] + qv[6] * n1[2] + qv[7] * n1[3];
    }
    qn += __shfl_xor(qn, 32);
    f32x16 O[4];
#pragma unroll
    for (int eb = 0; eb < 4; ++eb) {
#pragma unroll
        for (int i = 0; i < 16; ++i) O[eb][i] = 0.f;
#pragma unroll
        for (int ks = 0; ks < 4; ++ks) {
            const bf16x8 cf = *(const bf16x8*)(CPREV + (32 * eb + r) * 64 + 16 * ks + 8 * hl);
            O[eb] = __builtin_amdgcn_mfma_f32_32x32x16_bf16(cf, Qf[ks], O[eb], 0, 0, 0);
        }
#pragma unroll
        for (int i = 0; i < 16; ++i) O[eb][i] *= wi_l;
    }
    bf16x8 Kf[2][4];
#pragma unroll
    for (int t = 0; t < 2; ++t)
#pragma unroll
        for (int ks = 0; ks < 4; ++ks) Kf[t][ks] = *(const bf16x8*)(Z + (size_t)(row0 + 32 * t + r) * ZW + ZMK + hh * 64 + 16 * ks + 8 * hl);
    __syncthreads();
    float rs = 0.f;
    const float ebase = bt_l - mt_l;
#pragma unroll
    for (int t = 0; t < 2; ++t) {
        if (t > qb) break;
        f32x16 S;
#pragma unroll
        for (int i = 0; i < 16; ++i) S[i] = 0.f;
#pragma unroll
        for (int ks = 0; ks < 4; ++ks) S = __builtin_amdgcn_mfma_f32_32x32x16_bf16(Kf[t][ks], Qf[ks], S, 0, 0, 0);
#pragma unroll
        for (int i = 0; i < 16; ++i) { const int s = 32 * t + (i & 3) + 8 * (i >> 2) + 4 * hl;
            const float w = (s <= l) ? S[i] * 0.125f * __expf(sA[s] + ebase) : 0.f; S[i] = w; rs += w; }
#pragma unroll
        for (int s2 = 0; s2 < 2; ++s2) {
            u32x4 pbu; pbu[0] = pk_bf16(S[8 * s2 + 0], S[8 * s2 + 1]); pbu[1] = pk_bf16(S[8 * s2 + 2], S[8 * s2 + 3]); pbu[2] = pk_bf16(S[8 * s2 + 4], S[8 * s2 + 5]); pbu[3] = pk_bf16(S[8 * s2 + 6], S[8 * s2 + 7]);
            const bf16x8 pb = __builtin_bit_cast(bf16x8, pbu);
#pragma unroll
            for (int eb = 0; eb < 4; ++eb) {
                const bf16_t* vp = Vt + (32 * eb + r) * MVS + t * 32 + 16 * s2 + 4 * hl;
                u32x4 au; const u32x2 lo = *(const u32x2*)vp, hi = *(const u32x2*)(vp + 8); au[0] = lo[0]; au[1] = lo[1]; au[2] = hi[0]; au[3] = hi[1];
                O[eb] = __builtin_amdgcn_mfma_f32_32x32x16_bf16(__builtin_bit_cast(bf16x8, au), pb, O[eb], 0, 0, 0);
            }
        }
    }
    rs += __shfl_xor(rs, 32);
    const float den = rs + wi_l * qn;
    const float inv = 1.0f / fmaxf(fabsf(den), __expf(-mt_l));
    float ss = 0.f;
#pragma unroll
    for (int eb = 0; eb < 4; ++eb)
#pragma unroll
        for (int i = 0; i < 16; ++i) { const float hv = O[eb][i] * inv; O[eb][i] = hv; ss += hv * hv; }
    ss += __shfl_xor(ss, 32);
    const float rstd = rsqrtf(ss * (1.0f / 128.0f) + 1e-6f);
    __syncthreads();
    bf16_t* T = Vt;
    constexpr int TS = 136;
#pragma unroll
    for (int eb = 0; eb < 4; ++eb)
#pragma unroll
        for (int g4 = 0; g4 < 4; ++g4) {
            const int e0 = 32 * eb + 8 * g4 + 4 * hl;
            const f32x4 gh = *(const f32x4*)(p.g_head + hh * 128 + e0);
            u32x2 o; o[0] = pk_bf16(O[eb][4 * g4] * rstd * gh[0], O[eb][4 * g4 + 1] * rstd * gh[1]); o[1] = pk_bf16(O[eb][4 * g4 + 2] * rstd * gh[2], O[eb][4 * g4 + 3] * rstd * gh[3]);
            *(u32x2*)(T + l * TS + e0) = o;
        }
    __syncthreads();
    { const int tp = qb * 64 + lane;
#pragma unroll
      for (int i = 0; i < 8; ++i) { const int idx = tp + 128 * i, orow = idx >> 4, oc = idx & 15;
          const u32x4 pre = *(const u32x4*)(T + orow * TS + oc * 8); const u32x4 og = ogr[i];
          u32x4 o;
#pragma unroll
          for (int k = 0; k < 4; ++k) {
              const float v0 = bf_lo(pre[k]) * __builtin_amdgcn_rcpf(1.0f + __expf(-bf_lo(og[k]))), v1 = bf_hi(pre[k]) * __builtin_amdgcn_rcpf(1.0f + __expf(-bf_hi(og[k])));
              o[k] = pk_bf16(v0, v1); }
          *(u32x4*)(CAT + (size_t)(row0 + orow) * D + 512 + hh * 128 + oc * 8) = o; } }
    __syncthreads();
}

__device__ __forceinline__ void mlstm_sample_group(const Params& p, unsigned char* shm, int b) {
    const int tid = opaque_tid(), hh = tid >> 7, tp = tid & 127, lane = tid & 63, wv = (tid >> 6) & 1;
    const int unit = b * 4 + hh, row0 = MP + b * 8, e = tp;
    const bf16_t* Z = (const bf16_t*)(p.ws + WS_Z);
    const float* GT = (const float*)(p.ws + WS_GATES);
    bf16_t* CAT = (bf16_t*)(p.ws + WS_CAT);
    float* L = (float*)shm + hh * 3584;
    float* qs = L;
    float* ks = qs + 512;
    float* vs = ks + 512;
    float* Ss = vs + 1024;
    float* sm = Ss + 64;
    float* s_a = sm, *s_bt = sm + 8, *s_mt = sm + 16, *s_wi = sm + 24, *s_wk = sm + 32, *s_den = sm + 40, *s_misc = sm + 56;
    float* s_n = sm + 64;
    float* red = s_n + 64;
    f32x4 C4[16];
    { const float* Cin = p.st_C + (size_t)unit * 8192 + e * 64;
#pragma unroll
      for (int i = 0; i < 16; ++i) C4[i] = __builtin_nontemporal_load((const f32x4*)(Cin + 4 * i)); }
#pragma unroll
    for (int i = 0; i < 4; ++i) { const int idx = tp + 128 * i, t = idx >> 6, d = idx & 63; const bf16_t* zr = Z + (size_t)(row0 + t) * ZW;
        qs[idx] = bf2f(zr[ZMQ + hh * 64 + d]); ks[idx] = bf2f(zr[ZMK + hh * 64 + d]) * 0.125f; }
#pragma unroll
    for (int i = 0; i < 8; ++i) { const int idx = tp + 128 * i, t = idx >> 7, ee = idx & 127; vs[idx] = bf2f(Z[(size_t)(row0 + t) * ZW + ZMV + hh * 128 + ee]); }
    if (tp < 64) s_n[tp] = p.st_n[unit * 64 + tp];
    if (tp == 0) {
        const float mprev = p.st_m[unit];
        float bt = 0.f, cm = -INFINITY;
        for (int t = 0; t < 8; ++t) {
            const float lf = GT[(size_t)(row0 + t) * 8 + 4 + hh], ig = GT[(size_t)(row0 + t) * 8 + hh];
            bt += lf; const float a = ig - bt; cm = fmaxf(cm, a);
            const float mt = bt + fmaxf(cm, mprev);
            s_a[t] = a; s_bt[t] = bt; s_mt[t] = mt; s_wi[t] = __expf(bt + mprev - mt);
        }
        const float bL = bt, mnew = s_mt[7];
        for (int t = 0; t < 8; ++t) s_wk[t] = __expf(s_a[t] + bL - mnew);
        s_misc[0] = __expf(bL + mprev - mnew);
        p.out[O_MS + unit] = mnew;
    }
    __syncthreads();
    if (tp < 64) { const int l = tp >> 3, s = tp & 7; float a = 0.f;
#pragma unroll 8
        for (int d = 0; d < 64; ++d) a += qs[l * 64 + d] * ks[s * 64 + d];
        Ss[tp] = (s <= l) ? a * __expf(s_a[s] + s_bt[l] - s_mt[l]) : 0.f; }
    float* n2s = red + 16;
#pragma unroll 1
    for (int l = 0; l < 8; ++l) { float a = 0.f;
#pragma unroll
        for (int i = 0; i < 16; ++i) { const f32x4 q4 = *(const f32x4*)(qs + l * 64 + 4 * i); a += q4[0] * C4[i][0] + q4[1] * C4[i][1] + q4[2] * C4[i][2] + q4[3] * C4[i][3]; }
        n2s[l * 128 + e] = a; }
    __syncthreads();
    if (tp < 8) { float dn = 0.f; for (int s = 0; s < 8; ++s) dn += Ss[tp * 8 + s]; float qn = 0.f;
#pragma unroll 8
        for (int d = 0; d < 64; ++d) qn += qs[tp * 64 + d] * s_n[d];
        dn += s_wi[tp] * qn; s_den[tp] = fmaxf(fabsf(dn), __expf(-s_mt[tp])); }
    float hv[8];
#pragma unroll
    for (int l = 0; l < 8; ++l) { float n1 = 0.f;
#pragma unroll
        for (int s = 0; s < 8; ++s) n1 += Ss[l * 8 + s] * vs[s * 128 + e];
        hv[l] = n1 + s_wi[l] * n2s[l * 128 + e]; }
    __syncthreads();
#pragma unroll
    for (int l = 0; l < 8; ++l) { hv[l] = hv[l] / s_den[l]; const float ss = wave_sum(hv[l] * hv[l]); if (lane == 0) red[l * 2 + wv] = ss; }
    __syncthreads();
#pragma unroll
    for (int l = 0; l < 8; ++l) {
        const float rstd = rsqrtf((red[l * 2] + red[l * 2 + 1]) * (1.0f / 128.0f) + 1e-6f);
        const float og = bf2f(Z[(size_t)(row0 + l) * ZW + ZOG + hh * 128 + e]);
        const float o = hv[l] * rstd * p.g_head[hh * 128 + e] / (1.0f + __expf(-og));
        CAT[(size_t)(row0 + l) * D + 512 + hh * 128 + e] = (bf16_t)(pk_bf16(o, o) & 0xffffu);
    }
    { const float wc = s_misc[0]; float vw[8];
#pragma unroll
      for (int s = 0; s < 8; ++s) vw[s] = s_wk[s] * vs[s * 128 + e];
      float* Cout = p.out + O_CS + (size_t)unit * 8192 + e * 64;
#pragma unroll
      for (int i = 0; i < 16; ++i) { f32x4 c = C4[i] * wc;
#pragma unroll
          for (int s = 0; s < 8; ++s) c += *(const f32x4*)(ks + s * 64 + 4 * i) * vw[s];
          *(f32x4*)(Cout + 4 * i) = c;
          asm volatile("" ::: "memory"); }
      if (tp < 64) { float nn = wc * s_n[tp];
#pragma unroll
          for (int s = 0; s < 8; ++s) nn += s_wk[s] * ks[s * 64 + tp];
          p.out[O_NS + unit * 64 + tp] = nn; } }
    __syncthreads();
}

__device__ __forceinline__ void rms_final(const Params& p) {
    const int tid = opaque_tid(), lane = tid & 63, wid = tid >> 6;
    float* Y = p.out + O_Y;
    const bf16_t* XB = (const bf16_t*)(p.ws + WS_XN);
    const int stride = gridDim.x * 8;
    for (int row0 = blockIdx.x * 8 + wid; row0 < M; row0 += 2 * stride) {
        f32x4 v[2][4];
#pragma unroll
        for (int q = 0; q < 2; ++q) { const int row = row0 + q * stride;
            if (row < M) {
                const bf16_t* xb = XB + (size_t)row * D;
#pragma unroll
                for (int i = 0; i < 4; ++i) { const u32x2 w = *(const u32x2*)(xb + 4 * (lane + 64 * i)); v[q][i] = (f32x4){bf_lo(w[0]), bf_hi(w[0]), bf_lo(w[1]), bf_hi(w[1])}; }
                if (row >= MP) {
                    const bf16_t* sb = (const bf16_t*)(p.ws + WS_SLAB) + (size_t)(row - MP) * D;
#pragma unroll
                    for (int s = 0; s < 11; ++s)
#pragma unroll
                        for (int i = 0; i < 4; ++i) { const u32x2 w = *(const u32x2*)(sb + (size_t)s * MS * D + 4 * (lane + 64 * i)); v[q][i] += (f32x4){bf_lo(w[0]), bf_hi(w[0]), bf_lo(w[1]), bf_hi(w[1])}; }
                }
            } else {
#pragma unroll
                for (int i = 0; i < 4; ++i) v[q][i] = (f32x4){0.f, 0.f, 0.f, 0.f};
            } }
        f32x4 gv[4];
#pragma unroll
        for (int i = 0; i < 4; ++i) gv[i] = *(const f32x4*)(p.g_final + 4 * (lane + 64 * i));
#pragma unroll
        for (int q = 0; q < 2; ++q) { const int row = row0 + q * stride;
            float ss = 0.f;
#pragma unroll
            for (int i = 0; i < 4; ++i) ss += v[q][i][0] * v[q][i][0] + v[q][i][1] * v[q][i][1] + v[q][i][2] * v[q][i][2] + v[q][i][3] * v[q][i][3];
            ss = wave_sum(ss);
            const float rstd = rsqrtf(ss * (1.0f / D) + 1e-6f);
            if (row < M) {
#pragma unroll
                for (int i = 0; i < 4; ++i) __builtin_nontemporal_store(v[q][i] * rstd * gv[i], (f32x4*)(Y + (size_t)row * D + 4 * (lane + 64 * i)));
            } }
    }
}


#define XB_TMO      128
#define XB_XCNT(j)  (256  + 64 * (j))
#define XB_XSUB(j)  (1280 + 64 * (j))
#define XB_XGEN(j)  (2304 + 64 * (j))
#define XB_TOP      3328
#define XB_TOPGEN   3392
#define XCD_BAR_WORDS 3456
#define XB_SPIN_CAP (1u << 18)
__device__ __forceinline__ unsigned xb_ld(unsigned* p)              { return __hip_atomic_load(p, __ATOMIC_RELAXED, __HIP_MEMORY_SCOPE_AGENT); }
__device__ __forceinline__ unsigned xb_add(unsigned* p, unsigned v) { return __hip_atomic_fetch_add(p, v, __ATOMIC_RELAXED, __HIP_MEMORY_SCOPE_AGENT); }
__device__ __forceinline__ unsigned xb_xcc_id() { return (unsigned)__builtin_amdgcn_s_getreg((3 << 11) | 20) & 0xFu; }
#define XB_SPIN(cond, bar) do { unsigned _sp = 0; while (cond) { __builtin_amdgcn_s_sleep(1); \
    if ((++_sp & 255u) == 0u) { if (xb_ld(&(bar)[XB_TMO])) break; if (_sp > XB_SPIN_CAP) { atomicAdd(&(bar)[XB_TMO], 1u); break; } } } } while (0)
struct XcdBarrier { unsigned* bar; unsigned x; volatile LAS unsigned* st; };
__device__ __forceinline__ XcdBarrier xcd_barrier_post(unsigned* bar, volatile LAS unsigned* st) {
    XcdBarrier b; b.bar = bar; b.x = xb_xcc_id(); b.st = st;
    if (threadIdx.x == 0) (void)xb_add(&bar[XB_XCNT(b.x)], 1u);
    return b;
}
__device__ __forceinline__ void xcd_barrier_complete(unsigned* bar, unsigned x, unsigned& nloc, unsigned& nx) {
    const unsigned G = gridDim.x * gridDim.y * gridDim.z;
    unsigned sum, cnt, mine, sp = 0u;
    for (;;) {
        sum = 0u; cnt = 0u; mine = 0u;
#pragma unroll
        for (unsigned j = 0; j < 16; ++j) { const unsigned c = xb_ld(&bar[XB_XCNT(j)]); sum += c; cnt += (c > 0u) ? 1u : 0u; mine = (j == x) ? c : mine; }
        if (sum == G) break;
        __builtin_amdgcn_s_sleep(1);
        if ((++sp & 255u) == 0u) { if (xb_ld(&bar[XB_TMO])) break; if (sp > XB_SPIN_CAP) { atomicAdd(&bar[XB_TMO], 1u); break; } }
    }
    nloc = mine > 0u ? mine : 1u; nx = cnt > 0u ? cnt : 1u;
}
__device__ __forceinline__ void xcd_barrier(const XcdBarrier& b) {
    asm volatile("s_waitcnt vmcnt(0)" ::: "memory");
    __syncthreads();
    if (threadIdx.x == 0) {
        unsigned* bar = b.bar;
        __builtin_amdgcn_s_waitcnt(0);
        unsigned nloc = b.st[0], nx = b.st[1];
        if (nloc == 0u) { xcd_barrier_complete(bar, b.x, nloc, nx); b.st[0] = nloc; b.st[1] = nx; }
        const unsigned old = xb_add(&bar[XB_XSUB(b.x)], 1u);
        const unsigned gen = old / nloc;
        if (old + 1u == (gen + 1u) * nloc) {
            __builtin_amdgcn_fence(__ATOMIC_RELEASE, "agent");
            asm volatile("s_waitcnt vmcnt(0)" ::: "memory");
            const unsigned og = xb_add(&bar[XB_TOP], 1u);
            const unsigned tg = og / nx;
            if (og + 1u == (tg + 1u) * nx) xb_add(&bar[XB_TOPGEN], 1u);
            else XB_SPIN(xb_ld(&bar[XB_TOPGEN]) == tg, bar);
            __builtin_amdgcn_fence(__ATOMIC_ACQUIRE, "agent");
            xb_add(&bar[XB_XGEN(b.x)], 1u);
            asm volatile("s_waitcnt vmcnt(0)" ::: "memory");
        } else {
            XB_SPIN(xb_ld(&bar[XB_XGEN(b.x)]) == gen, bar);
            __builtin_amdgcn_fence(__ATOMIC_ACQUIRE, "agent");
            asm volatile("s_waitcnt vmcnt(0)" ::: "memory");
        }
    }
    __syncthreads();
}

__global__ void __launch_bounds__(NTHREADS, 2) fwd_megakernel(Params p) {
    extern __shared__ __attribute__((aligned(16))) unsigned char shm[];
    cg::grid_group grid = cg::this_grid();
    const int G = gridDim.x, bid = blockIdx.x, tid = threadIdx.x;
    bf16_t* XN = (bf16_t*)(p.ws + WS_XN);

    volatile LAS unsigned* xst = (volatile LAS unsigned*)((LAS unsigned char*)shm + LDS_BYTES - 16);
    if (tid == 0) { xst[0] = 0u; xst[1] = 0u; }
    __syncthreads();
    const XcdBarrier xbar = xcd_barrier_post((unsigned*)(p.ws + WS_BAR), xst);
    const bool late_tiles = (G == 256);
    phase0(p, shm, !late_tiles);
    if (p.out == nullptr) grid.sync();
    xcd_barrier(xbar);
#define RUN_GEMM(GG, EE, CSH) do { const pg8::Gemm g_ = GG; const Epi E_ = EE; pg8::StaticOrder S_; S_.init(g_.M, g_.N, G, (bid + (CSH)) % G); gemm_phase(p, (LAS unsigned char*)shm, g_, S_, E_); } while (0)
    RUN_GEMM((pg8::Gemm{XN, (const bf16_t*)(p.ws + WS_WIN), M, ZW, D, D}), (Epi{EM_BF16, 1, ZW, (bf16_t*)(p.ws + WS_Z), nullptr, nullptr, nullptr}), 0);
    RUN_GEMM((pg8::Gemm{(const bf16_t*)(p.ws + WS_MN), (const bf16_t*)(p.ws + WS_WCKV), 1024, 512, D, D}), (Epi{EM_MEMKV, 0, 512, (bf16_t*)(p.ws + WS_MEMKV), nullptr, nullptr, nullptr}), 128);
    if (late_tiles && bid >= 100 && !(bid >= 128 && bid < 136)) conv_tiles(p, shm, T_EARLY, T_MID, bid < 128 ? bid - 100 : bid - 108, 148);
    xcd_barrier(xbar);
    {
        for (int u = bid; u < 256; u += G) swa_prompt_unit(p, shm, u);
        for (int u = bid; u < NUNIT / 4; u += G) mlstm_local_group(p, shm, u);
        for (int u = bid; u < 256; u += G) { if (u < 128) mlstm_sample_group(p, shm, u); else swa_sample_unit(p, shm, u - 128); }
        const bf16_t* Z = (const bf16_t*)(p.ws + WS_Z);
        for (int idx = bid * NTHREADS + tid; idx < 4 * 128 * 128; idx += G * NTHREADS) {
            const int col = idx & 127, j = (idx >> 7) & 127, b = idx >> 14;
            const bf16_t* zr = Z + (size_t)(b * SEQ + SEQ - 128 + j) * ZW;
            p.out[O_SKP + idx] = bf2f(zr[ZK + col]); p.out[O_SVP + idx] = bf2f(zr[ZV + col]); }
    }
    xcd_barrier(xbar);
    mlstm_scan(p);
    xcd_barrier(xbar);
    for (int u = bid; u < NUNIT / 4; u += G) mlstm_out_group(p, shm, u);
    xcd_barrier(xbar);
    float* SSQ1 = (float*)(p.ws + WS_SSQ1); float* SSQ2 = (float*)(p.ws + WS_SSQ2);
    RUN_GEMM((pg8::Gemm{(const bf16_t*)(p.ws + WS_CAT), (const bf16_t*)(p.ws + WS_WOUT), M, D, D, D}), (Epi{EM_RES_X, 1, D, XN, nullptr, nullptr, SSQ1}), 0);
    xcd_barrier(xbar);
    RUN_GEMM((pg8::Gemm{XN, (const bf16_t*)(p.ws + WS_WCQ), M, 256, D, D}), (Epi{EM_BF16, 1, 256, (bf16_t*)(p.ws + WS_Q2), nullptr, nullptr, SSQ1}), 0);
    if (late_tiles && bid >= 68) conv_tiles(p, shm, T_MID, T_ALL, bid - 68, 188);
    xcd_barrier(xbar);
    {
        for (int u = bid; u < 256; u += G) cross_prompt_unit(p, shm, u);
        for (int u = bid; u < 512; u += G) cross_sample_unit(p, shm, u);
    }
    xcd_barrier(xbar);
    const bool split_co = (G == 256);
    RUN_GEMM((pg8::Gemm{(const bf16_t*)(p.ws + WS_O2), (const bf16_t*)(p.ws + WS_WCO), split_co ? MP : M, D, 256, 256}), (Epi{EM_RES_Y, 1, D, XN, nullptr, nullptr, SSQ2}), 0);
    xcd_barrier(xbar);
    unsigned* DEP = (unsigned*)(p.ws + WS_DEP);
    if (split_co && bid >= 240) {
        const int tl = bid - 240;
        const pg8::Gemm g_ = {(const bf16_t*)(p.ws + WS_O2), (const bf16_t*)(p.ws + WS_WCO), M, D, 256, 256};
        const Epi E_ = {EM_RES_Y, 1, D, XN, nullptr, nullptr, SSQ2};
        pg8::StaticOrder S_; S_.init(M, D, G, 0); S_.spm = 64 + (tl >> 2); S_.spn = tl & 3;
        gemm_phase(p, (LAS unsigned char*)shm, g_, S_, E_);
        asm volatile("s_waitcnt vmcnt(0)" ::: "memory");
        __syncthreads();
        if (tid == 0) { __builtin_amdgcn_fence(__ATOMIC_RELEASE, "agent"); asm volatile("s_waitcnt vmcnt(0)" ::: "memory");
            (void)__hip_atomic_fetch_add(DEP, 1u, __ATOMIC_RELAXED, __HIP_MEMORY_SCOPE_AGENT); }
    }
    RUN_GEMM((pg8::Gemm{XN, (const bf16_t*)(p.ws + WS_WGU), M, 2 * FFN, D, D}), (Epi{EM_SWIGLU, 1, FFN, (bf16_t*)(p.ws + WS_H), nullptr, split_co ? DEP : nullptr, SSQ2}), 0);
    xcd_barrier(xbar);
    RUN_GEMM((pg8::Gemm{(const bf16_t*)(p.ws + WS_H), (const bf16_t*)(p.ws + WS_WD), MP, D, FFN, FFN}), (Epi{EM_RES_Y, 1, D, XN, nullptr, nullptr, nullptr}), 0);
    {
        const int su = (bid + 80) % G;
        const int sl = su >> 4, tl = su & 15;
        const pg8::Gemm g_ = {(const bf16_t*)(p.ws + WS_H) + sl * 256, (const bf16_t*)(p.ws + WS_WD) + sl * 256, M, D, 256, FFN};
        const Epi E_ = {EM_SLAB, 0, D, nullptr, (float*)((bf16_t*)(p.ws + WS_SLAB) + (size_t)sl * MS * D), nullptr, nullptr};
        pg8::StaticOrder S_; S_.init(M, D, G, su < 176 ? 0 : -1); S_.spm = 64 + (tl >> 2); S_.spn = tl & 3;
        gemm_phase(p, (LAS unsigned char*)shm, g_, S_, E_);
    }
    xcd_barrier(xbar);
    rms_final(p);
}

extern "C" void kernel_launch(void* const* d_in, const int* in_sizes, int n_in, void* d_out, int out_size, void* d_ws, size_t ws_size, hipStream_t stream) {
    static int grid = 0;
    if (grid == 0) {
        int dev = 0, cus = 0, per_cu = 0;
        (void)hipGetDevice(&dev);
        (void)hipDeviceGetAttribute(&cus, hipDeviceAttributeMultiprocessorCount, dev);
        (void)hipFuncSetAttribute((const void*)fwd_megakernel, hipFuncAttributeMaxDynamicSharedMemorySize, LDS_BYTES);
        (void)hipOccupancyMaxActiveBlocksPerMultiprocessor(&per_cu, (const void*)fwd_megakernel, NTHREADS, LDS_BYTES);
        if (per_cu < 1) per_cu = 1;
        if (per_cu > 1) per_cu = 1;
        grid = cus * per_cu;
        if (ws_size < WS_END || n_in != 28 || (size_t)out_size != O_END) fprintf(stderr, "kernel_launch: unexpected sizes ws %zu (need %zu) n_in %d out %d\n", ws_size, (size_t)WS_END, n_in, out_size);
    }
    Params p{};
    const float** pp = (const float**)&p;
    for (int i = 0; i < 28; ++i) pp[i] = (const float*)d_in[i];
    p.out = (float*)d_out; p.ws = (unsigned char*)d_ws;
    (void)hipMemsetAsync((unsigned char*)d_ws + WS_BAR, 0, WS_ZERO_BYTES, stream);
    void* args[] = {&p};
    hipError_t e = hipLaunchCooperativeKernel((const void*)fwd_megakernel, dim3(grid), dim3(NTHREADS), args, LDS_BYTES, stream);
    if (e != hipSuccess) fprintf(stderr, "cooperative launch failed: %s (grid %d)\n", hipGetErrorString(e), grid);
}
```

```cpp
#include <hip/hip_runtime.h>
#include <hip/hip_cooperative_groups.h>
#include <cstdio>
#include <cstdint>
namespace cg = cooperative_groups;

#define LAS __attribute__((address_space(3)))
typedef unsigned short bf16_t;
typedef short bf16x8 __attribute__((ext_vector_type(8)));
typedef short bf16x4 __attribute__((ext_vector_type(4)));
typedef float f32x4 __attribute__((ext_vector_type(4)));
typedef float f32x16 __attribute__((ext_vector_type(16)));
typedef unsigned u32x4 __attribute__((ext_vector_type(4)));
typedef unsigned u32x2 __attribute__((ext_vector_type(2)));

constexpr int D = 1024, MP = 16384, MS = 1024, M = MP + MS, SEQ = 4096;
constexpr int INW = 2312, ZW = 2304, FFN = 2816;
constexpr int ZQ = 0, ZK = 512, ZV = 640, ZMQ = 768, ZMK = 1024, ZMV = 1280, ZOG = 1792;
constexpr int NUNIT = 1024;
constexpr size_t O_Y = 0, O_SKP = (size_t)M * D, O_SVP = O_SKP + 65536, O_CP = O_SVP + 65536, O_NP = O_CP + 131072, O_MP = O_NP + 1024,
                 O_MKP = O_MP + 16, O_MVP = O_MKP + 262144, O_SKS = O_MVP + 262144, O_SVS = O_SKS + 2097152, O_CS = O_SVS + 2097152,
                 O_NS = O_CS + 4194304, O_MS = O_NS + 32768, O_END = O_MS + 512;
constexpr size_t al256(size_t x) { return (x + 255) & ~(size_t)255; }
constexpr size_t WS_WIN = 0;
constexpr size_t WS_WOUT = WS_WIN + (size_t)ZW * D * 2;
constexpr size_t WS_WCQ = WS_WOUT + (size_t)D * D * 2;
constexpr size_t WS_WCKV = WS_WCQ + (size_t)256 * D * 2;
constexpr size_t WS_WCO = WS_WCKV + (size_t)512 * D * 2;
constexpr size_t WS_WGU = WS_WCO + (size_t)D * 256 * 2;
constexpr size_t WS_WD = WS_WGU + (size_t)2 * FFN * D * 2;
constexpr size_t WS_XN = WS_WD + (size_t)D * FFN * 2;
constexpr size_t WS_MN = WS_XN + (size_t)M * D * 2;
constexpr size_t WS_GATES = WS_MN + (size_t)1024 * D * 2;
constexpr size_t WS_MEMKV = WS_GATES + (size_t)M * 8 * 4;
constexpr size_t WS_SCAL = WS_MEMKV + (size_t)1024 * 512 * 2;
constexpr size_t WS_NT = WS_SCAL + 3 * 4096;
constexpr size_t WS_NPREV = WS_NT + (size_t)NUNIT * 64 * 4;
constexpr size_t WS_Z = WS_NPREV + (size_t)NUNIT * 64 * 4;
constexpr size_t WS_CAT = WS_Z + (size_t)M * ZW * 2;
constexpr size_t WS_H = WS_Z;
constexpr size_t WS_UT = WS_CAT + (size_t)M * D * 2;
constexpr size_t WS_Q2 = WS_UT;
constexpr size_t WS_O2 = WS_Q2 + (size_t)M * 256 * 2;
constexpr size_t WS_SLAB = WS_UT;
constexpr size_t WS_CPREV = WS_UT + (size_t)NUNIT * 8192 * 4;
constexpr size_t WS_BAR = WS_CPREV + (size_t)NUNIT * 8192 * 2;
constexpr size_t WS_SSQ1 = WS_BAR + 16384;
constexpr size_t WS_SSQ2 = WS_SSQ1 + (size_t)M * 4;
constexpr size_t WS_DEP = WS_SSQ2 + (size_t)M * 4;
constexpr size_t WS_ZERO_BYTES = 16384 + 2 * (size_t)M * 4 + 256;
constexpr size_t WS_END = WS_DEP + 256;
static_assert((size_t)M * FFN * 2 <= (size_t)M * ZW * 2 + (size_t)M * D * 2, "H overlay");
static_assert(WS_END <= (size_t)256 * 1024 * 1024, "workspace");
static_assert((size_t)11 * MS * D * 4 <= (size_t)NUNIT * 8192 * 4 + (size_t)NUNIT * 8192 * 2, "slab overlay");

constexpr int LDS_BYTES = 140 * 1024;
constexpr int NTHREADS = 512;

struct Params {
    const float *x_prompt, *x_sample, *mem_prompt, *cache_swa_k, *cache_swa_v, *st_C, *st_n, *st_m, *cache_mem_k, *cache_mem_v,
        *w_in, *b_ig, *b_fg, *sinks, *g_head, *w_out, *g_mix, *g_cross, *g_mem, *w_cq, *w_ck, *w_cv, *w_co, *g_ffn, *w_gate, *w_up, *w_down, *g_final;
    float* out;
    unsigned char* ws;
};

__device__ __forceinline__ unsigned pk_bf16(float lo, float hi) { unsigned r; asm volatile("v_cvt_pk_bf16_f32 %0, %1, %2" : "=v"(r) : "v"(lo), "v"(hi)); return r; }
__device__ __forceinline__ float bf_lo(unsigned u) { return __uint_as_float(u << 16); }
__device__ __forceinline__ float bf_hi(unsigned u) { return __uint_as_float(u & 0xffff0000u); }
__device__ __forceinline__ float bf2f(bf16_t b) { return __uint_as_float(((unsigned)b) << 16); }
__device__ __forceinline__ const float* xrow(const Params& p, int r) { return r < MP ? p.x_prompt + (size_t)r * D : p.x_sample + (size_t)(r - MP) * D; }
__device__ __forceinline__ int opaque_tid() { int t = threadIdx.x; asm volatile("" : "+v"(t)); return t; }
__device__ __forceinline__ float wave_sum(float v) {
#pragma unroll
    for (int o = 32; o > 0; o >>= 1) v += __shfl_xor(v, o);
    return v;
}
__device__ __forceinline__ float wave_max(float v) {
#pragma unroll
    for (int o = 32; o > 0; o >>= 1) v = fmaxf(v, __shfl_xor(v, o));
    return v;
}
__device__ __forceinline__ float wave_scan_add(float v, int lane) {
#pragma unroll
    for (int o = 1; o < 64; o <<= 1) { float t = __shfl_up(v, o); if (lane >= o) v += t; }
    return v;
}
__device__ __forceinline__ float wave_scan_max(float v, int lane) {
#pragma unroll
    for (int o = 1; o < 64; o <<= 1) { float t = __shfl_up(v, o); if (lane >= o) v = fmaxf(v, t); }
    return v;
}

namespace pg8 {
constexpr int BM = 256, BK = 64, HALF = 128, HTB = HALF * BK * 2, STAGE_BYTES = 8 * HTB, NXCD = 8, WGM = 8;
__device__ __forceinline__ int lds_byte(int r, int c) { const int st = (r >> 4) * 2 + (c >> 5), rr = r & 15, cc = c & 31, ob = rr * 64 + cc * 2; return st * 1024 + (ob ^ (((ob >> 9) & 1) << 5)); }
__device__ __forceinline__ void stage_rc(int b, int& R, int& C) { const int st = b / 1024, sb = b % 1024, swz = sb ^ (((sb >> 9) & 1) << 5); R = (st >> 1) * 16 + swz / 64; C = (st & 1) * 32 + (swz % 64) / 2; }
__device__ __forceinline__ int perm32(int rho) { const int n = rho >> 4, i = rho & 15; return 8 * (i >> 2) + 4 * n + (i & 3); }
struct Unit { int pm, pn; };
struct Gemm { const bf16_t* A; const bf16_t* Bt; int M, N, K, ld; };
struct StaticOrder {
    int nM, nN, nwg, G, c, spm, spn;
    __device__ void init(int M_, int N_, int G_, int c_) { nM = M_ / BM; nN = N_ / BM; nwg = nM * nN; G = G_; c = c_; spm = -1; spn = 0; }
    __device__ bool next(int i, Unit& u) const {
        if (spm >= 0) { if (i > 0 || c < 0) return false; u.pm = spm; u.pn = spn; return true; }
        const long L = (long)i * G + c; if (L >= nwg) return false;
        int wgid = (int)L; { const int q = nwg / NXCD, r = nwg % NXCD, xcd = wgid % NXCD, off = wgid / NXCD; wgid = (xcd < r ? xcd * (q + 1) : r * (q + 1) + (xcd - r) * q) + off; }
        const int nig = WGM * nN, gid = wgid / nig, fm = gid * WGM, gsz = (nM - fm) < WGM ? (nM - fm) : WGM;
        u.pm = fm + ((wgid % nig) % gsz); u.pn = (wgid % nig) / gsz; return true;
    }
};
}

enum { EM_BF16 = 0, EM_SWIGLU = 1, EM_RES_X = 2, EM_RES_Y = 3, EM_MEMKV = 4, EM_DUMMY = 5, EM_SLAB = 6 };
struct Epi {
    int mode, perm, ldc;
    bf16_t* O;
    float* Y;
    unsigned* dep;
    float* ssq;
};

__device__ __forceinline__ float silu_f(float g) { return g * __builtin_amdgcn_rcpf(1.0f + __expf(-g)); }

__device__ __forceinline__ void epi_apply(const Params& p, const Epi& E, const f32x4 (&acc)[2][2][4][2], const pg8::Unit& u, int wr, int wc, int fr, int fq) {
    const int row0 = u.pm * 256 + wr * 64 + fr;
    if (E.mode == EM_BF16) {
        const int col0 = u.pn * 256 + wc * 32 + 8 * fq;
        float rsv[2][4];
#pragma unroll
        for (int ai = 0; ai < 2; ++ai)
#pragma unroll
            for (int m = 0; m < 4; ++m) rsv[ai][m] = E.ssq ? E.ssq[row0 + ai * 128 + m * 16] : 0.f;
#pragma unroll
        for (int ai = 0; ai < 2; ++ai)
#pragma unroll
            for (int m = 0; m < 4; ++m) {
                bf16_t* rowp = E.O + (size_t)(row0 + ai * 128 + m * 16) * E.ldc + col0;
                const float rs = E.ssq ? rsqrtf(rsv[ai][m] * (1.0f / D) + 1e-6f) : 1.0f;
#pragma unroll
                for (int bj = 0; bj < 2; ++bj) {
                    const f32x4 v0 = acc[ai][bj][m][0] * rs, v1 = acc[ai][bj][m][1] * rs;
                    u32x4 o; o[0] = pk_bf16(v0[0], v0[1]); o[1] = pk_bf16(v0[2], v0[3]); o[2] = pk_bf16(v1[0], v1[1]); o[3] = pk_bf16(v1[2], v1[3]);
                    *(u32x4*)(rowp + bj * 128) = o;
                }
            }
    } else if (E.mode == EM_SWIGLU) {
        const int col0 = u.pn * 128 + wc * 32 + 8 * fq;
        float rsv[2][4];
#pragma unroll
        for (int ai = 0; ai < 2; ++ai)
#pragma unroll
            for (int m = 0; m < 4; ++m) rsv[ai][m] = E.ssq ? E.ssq[row0 + ai * 128 + m * 16] : 0.f;
#pragma unroll
        for (int ai = 0; ai < 2; ++ai)
#pragma unroll
            for (int m = 0; m < 4; ++m) {
                bf16_t* rowp = E.O + (size_t)(row0 + ai * 128 + m * 16) * E.ldc + col0;
                const float rs = E.ssq ? rsqrtf(rsv[ai][m] * (1.0f / D) + 1e-6f) : 1.0f;
                const f32x4 g0 = acc[ai][0][m][0] * rs, g1 = acc[ai][0][m][1] * rs, u0 = acc[ai][1][m][0] * rs, u1 = acc[ai][1][m][1] * rs;
                u32x4 o;
                o[0] = pk_bf16(silu_f(g0[0]) * u0[0], silu_f(g0[1]) * u0[1]); o[1] = pk_bf16(silu_f(g0[2]) * u0[2], silu_f(g0[3]) * u0[3]);
                o[2] = pk_bf16(silu_f(g1[0]) * u1[0], silu_f(g1[1]) * u1[1]); o[3] = pk_bf16(silu_f(g1[2]) * u1[2], silu_f(g1[3]) * u1[3]);
                *(u32x4*)rowp = o;
            }
    } else if (E.mode == EM_RES_X || E.mode == EM_RES_Y) {
        const int col0 = u.pn * 256 + wc * 32 + 8 * fq;
        float ssr[2][4];
#pragma unroll
        for (int ai = 0; ai < 2; ++ai) {
            f32x4 rr[4][2][2];
#pragma unroll
            for (int m = 0; m < 4; ++m) {
                const int row = row0 + ai * 128 + m * 16;
                if (E.mode == EM_RES_X) {
                    const float* rp = xrow(p, row) + col0;
#pragma unroll
                    for (int bj = 0; bj < 2; ++bj)
#pragma unroll
                        for (int n = 0; n < 2; ++n) rr[m][bj][n] = *(const f32x4*)(rp + bj * 128 + n * 4);
                } else {
                    const bf16_t* rp = E.O + (size_t)row * D + col0;
#pragma unroll
                    for (int bj = 0; bj < 2; ++bj) { const u32x4 q = *(const u32x4*)(rp + bj * 128);
                        rr[m][bj][0] = (f32x4){bf_lo(q[0]), bf_hi(q[0]), bf_lo(q[1]), bf_hi(q[1])}; rr[m][bj][1] = (f32x4){bf_lo(q[2]), bf_hi(q[2]), bf_lo(q[3]), bf_hi(q[3])}; }
                }
            }
#pragma unroll
            for (int m = 0; m < 4; ++m) {
                const int row = row0 + ai * 128 + m * 16;
                float ss = 0.f;
#pragma unroll
                for (int bj = 0; bj < 2; ++bj) {
                    const f32x4 y0 = acc[ai][bj][m][0] + rr[m][bj][0], y1 = acc[ai][bj][m][1] + rr[m][bj][1];
                    if (E.Y) { *(f32x4*)(E.Y + (size_t)row * D + col0 + bj * 128) = y0; *(f32x4*)(E.Y + (size_t)row * D + col0 + bj * 128 + 4) = y1; }
                    else { u32x4 o; o[0] = pk_bf16(y0[0], y0[1]); o[1] = pk_bf16(y0[2], y0[3]); o[2] = pk_bf16(y1[0], y1[1]); o[3] = pk_bf16(y1[2], y1[3]); *(u32x4*)(E.O + (size_t)row * D + col0 + bj * 128) = o; }
                    ss += y0[0] * y0[0] + y0[1] * y0[1] + y0[2] * y0[2] + y0[3] * y0[3] + y1[0] * y1[0] + y1[1] * y1[1] + y1[2] * y1[2] + y1[3] * y1[3];
                }
                ssr[ai][m] = ss;
            }
        }
        if (E.ssq) {
#pragma unroll
            for (int ai = 0; ai < 2; ++ai)
#pragma unroll
                for (int m = 0; m < 4; ++m) { float ss = ssr[ai][m]; ss += __shfl_xor(ss, 16); ss += __shfl_xor(ss, 32);
                    if (fq == 0) (void)__hip_atomic_fetch_add(E.ssq + row0 + ai * 128 + m * 16, ss, __ATOMIC_RELAXED, __HIP_MEMORY_SCOPE_AGENT); }
        }
    } else if (E.mode == EM_SLAB) {
        const int col0 = u.pn * 256 + wc * 32 + 4 * fq;
#pragma unroll
        for (int ai = 0; ai < 2; ++ai)
#pragma unroll
            for (int m = 0; m < 4; ++m) {
                bf16_t* yp = (bf16_t*)E.Y + (size_t)(row0 - MP + ai * 128 + m * 16) * D + col0;
#pragma unroll
                for (int bj = 0; bj < 2; ++bj)
#pragma unroll
                    for (int n = 0; n < 2; ++n) { const f32x4 a = acc[ai][bj][m][n]; u32x2 o; o[0] = pk_bf16(a[0], a[1]); o[1] = pk_bf16(a[2], a[3]); *(u32x2*)(yp + bj * 128 + n * 16) = o; }
            }
    } else if (E.mode == EM_DUMMY) {
        if (acc[0][0][0][0][0] == 12345.678f && acc[1][1][3][1][3] == -777.25f) E.Y[row0] = acc[0][1][2][0][1];
    } else {
        const int col0 = u.pn * 256 + wc * 32 + 4 * fq;
        float* ob = p.out + (u.pn == 0 ? O_MKP : O_MVP);
#pragma unroll
        for (int ai = 0; ai < 2; ++ai)
#pragma unroll
            for (int m = 0; m < 4; ++m) {
                const int row = row0 + ai * 128 + m * 16;
#pragma unroll
                for (int bj = 0; bj < 2; ++bj)
#pragma unroll
                    for (int n = 0; n < 2; ++n) {
                        const int c = col0 + bj * 128 + n * 16;
                        const f32x4 v = acc[ai][bj][m][n];
                        *(f32x4*)(ob + (size_t)row * 256 + (c & 255)) = v;
                        u32x2 o; o[0] = pk_bf16(v[0], v[1]); o[1] = pk_bf16(v[2], v[3]);
                        *(u32x2*)(E.O + (size_t)row * 512 + c) = o;
                    }
            }
    }
}

__device__ __forceinline__ void gemm_phase(const Params& p, LAS unsigned char* lds, const pg8::Gemm g, const pg8::StaticOrder& S, const Epi& E) {
    using namespace pg8;
    int tid_ = threadIdx.x; asm volatile("" : "+v"(tid_));
    const int tid = tid_, wid = __builtin_amdgcn_readfirstlane(tid >> 6), lane = tid & 63, wr = wid >> 2, wc = wid & 3, fr = lane & 15, fq = lane >> 4;
    const int K = g.K, nt = K / BK;
    unsigned voffA[2], voffB[2];
#pragma unroll
    for (int i = 0; i < 2; ++i) { int R, C; stage_rc(tid * 16 + i * 8192, R, C); const int Rb = E.perm ? ((R & ~31) + perm32(R & 31)) : R;
        voffA[i] = (unsigned)(R * g.ld + C) * 2u; voffB[i] = (unsigned)(Rb * g.ld + C) * 2u; }
    const size_t kstep = (size_t)(BK * 2);
    const size_t hstep = (size_t)HALF * g.ld * 2;
    const size_t tstep = 2 * hstep;
    const unsigned ldsw = (unsigned)wid * 1024u;
    const int aoff = lds_byte(wr * 64 + fr, fq * 8), boff = lds_byte(wc * 32 + fr, fq * 8);
#define PG8_SA(b, h) (((b) * 2 + (h)) * HTB)
#define PG8_SB(b, h) ((4 + (b) * 2 + (h)) * HTB)
#define PG8_STAGE(bufoff, gbase, voff) do { _Pragma("unroll") for (int _i = 0; _i < 2; ++_i) \
        __builtin_amdgcn_global_load_lds((const unsigned*)((const char*)(gbase) + (voff)[_i]), (LAS unsigned*)(lds + (bufoff) + ldsw + _i * 8192), 16, 0, 0); } while (0)
#define PG8_LDA(dst, b, h) do { _Pragma("unroll") for (int m = 0; m < 4; ++m) _Pragma("unroll") for (int k = 0; k < 2; ++k) dst[m][k] = *(const LAS bf16x8*)(lds + PG8_SA(b, h) + aoff + m * 2048 + k * 1024); } while (0)
#define PG8_LDB(dst, b, h) do { _Pragma("unroll") for (int n = 0; n < 2; ++n) _Pragma("unroll") for (int k = 0; k < 2; ++k) dst[n][k] = *(const LAS bf16x8*)(lds + PG8_SB(b, h) + boff + n * 2048 + k * 1024); } while (0)
#define PG8_MMA(ai, bj, At, Bt) do { __builtin_amdgcn_s_setprio(1); _Pragma("unroll") for (int m = 0; m < 4; ++m) _Pragma("unroll") for (int n = 0; n < 2; ++n) _Pragma("unroll") for (int k = 0; k < 2; ++k) \
        acc[ai][bj][m][n] = __builtin_amdgcn_mfma_f32_16x16x32_bf16(Bt[n][k], At[m][k], acc[ai][bj][m][n], 0, 0, 0); __builtin_amdgcn_s_setprio(0); } while (0)
#define PG8_WAIT_V(n) asm volatile("s_waitcnt vmcnt(" #n ")" ::: "memory")
#define PG8_WAIT_L(n) asm volatile("s_waitcnt lgkmcnt(" #n ")" ::: "memory")
#define PG8_BAR __builtin_amdgcn_s_barrier()
#define PG8_SCHED __builtin_amdgcn_sched_barrier(0)
    Unit cur, nxt; int ui = 0;
    if (!S.next(0, cur)) return;
#define PG8_DEPWAIT() do { unsigned _sp = 0; while ((unsigned)__builtin_amdgcn_readfirstlane((int)__hip_atomic_load(E.dep, __ATOMIC_RELAXED, __HIP_MEMORY_SCOPE_AGENT)) < 16u) { __builtin_amdgcn_s_sleep(4); if (++_sp > (1u << 18)) break; } \
        __builtin_amdgcn_fence(__ATOMIC_ACQUIRE, "agent"); asm volatile("s_waitcnt vmcnt(0)" ::: "memory"); } while (0)
    if (E.dep && cur.pm >= 64) PG8_DEPWAIT();
    f32x4 acc[2][2][4][2];
#pragma unroll
    for (int a = 0; a < 2; ++a)
#pragma unroll
        for (int b = 0; b < 2; ++b)
#pragma unroll
            for (int m = 0; m < 4; ++m)
#pragma unroll
                for (int n = 0; n < 2; ++n) acc[a][b][m][n] = (f32x4){0.f, 0.f, 0.f, 0.f};
    bf16x8 At[4][2], B0[2][2], B1[2][2];
    const char* cA = (const char*)g.A + (size_t)cur.pm * tstep; const char* cB = (const char*)g.Bt + (size_t)cur.pn * tstep;
    PG8_STAGE(PG8_SB(0, 0), cB, voffB); PG8_STAGE(PG8_SB(0, 1), cB + hstep, voffB); PG8_STAGE(PG8_SA(0, 0), cA, voffA); PG8_STAGE(PG8_SA(0, 1), cA + hstep, voffA);
    if (wr == 1) PG8_BAR;
    PG8_WAIT_V(2); PG8_BAR;
    PG8_STAGE(PG8_SB(1, 0), cB + kstep, voffB); PG8_STAGE(PG8_SA(1, 0), cA + kstep, voffA); PG8_STAGE(PG8_SB(1, 1), cB + hstep + kstep, voffB);
    PG8_WAIT_V(6); PG8_BAR;
    for (;;) {
        const bool has_next = S.next(ui + 1, nxt);
        if (E.dep && has_next && nxt.pm >= 64 && cur.pm < 64) PG8_DEPWAIT();
        const char* nA = has_next ? (const char*)g.A + (size_t)nxt.pm * tstep : cA; const char* nB = has_next ? (const char*)g.Bt + (size_t)nxt.pn * tstep : cB;
        for (int t = 0; t < nt; t += 2) {
            const bool last = (t == nt - 2);
            const char* a1 = cA + (size_t)(t + 1) * kstep;
            const char* a2 = last ? nA : cA + (size_t)(t + 2) * kstep; const char* b2 = last ? nB : cB + (size_t)(t + 2) * kstep;
            const char* a3 = a2 + kstep; const char* b3 = b2 + kstep;
            PG8_LDB(B0, 0, 0); PG8_LDB(B1, 0, 1); PG8_SCHED; PG8_LDA(At, 0, 0); PG8_STAGE(PG8_SA(1, 1), a1 + hstep, voffA);
            PG8_WAIT_V(8); PG8_WAIT_L(0); PG8_BAR; PG8_MMA(0, 0, At, B0); PG8_MMA(0, 1, At, B1); PG8_BAR; PG8_SCHED;
            PG8_LDA(At, 0, 1); PG8_STAGE(PG8_SB(0, 0), b2, voffB); PG8_STAGE(PG8_SB(0, 1), b2 + hstep, voffB); PG8_STAGE(PG8_SA(0, 0), a2, voffA);
            PG8_WAIT_V(8); PG8_WAIT_L(0); PG8_BAR; PG8_MMA(1, 0, At, B0); PG8_MMA(1, 1, At, B1); PG8_BAR; PG8_SCHED;
            PG8_LDB(B0, 1, 0); PG8_LDB(B1, 1, 1); PG8_SCHED; PG8_LDA(At, 1, 0); PG8_STAGE(PG8_SA(0, 1), a2 + hstep, voffA);
            PG8_WAIT_V(8); PG8_WAIT_L(0); PG8_BAR; PG8_MMA(0, 0, At, B0); PG8_MMA(0, 1, At, B1); PG8_BAR; PG8_SCHED;
            PG8_LDA(At, 1, 1); PG8_STAGE(PG8_SB(1, 0), b3, voffB); PG8_STAGE(PG8_SB(1, 1), b3 + hstep, voffB); PG8_STAGE(PG8_SA(1, 0), a3, voffA);
            PG8_WAIT_V(8); PG8_WAIT_L(0); PG8_BAR; PG8_MMA(1, 0, At, B0); PG8_MMA(1, 1, At, B1); PG8_BAR; PG8_SCHED;
        }
        if (wr == 0) PG8_BAR;
        epi_apply(p, E, acc, cur, wr, wc, fr, fq);
        if (!has_next) break;
#pragma unroll
        for (int a = 0; a < 2; ++a)
#pragma unroll
            for (int b = 0; b < 2; ++b)
#pragma unroll
                for (int m = 0; m < 4; ++m)
#pragma unroll
                    for (int n = 0; n < 2; ++n) acc[a][b][m][n] = (f32x4){0.f, 0.f, 0.f, 0.f};
        cur = nxt; cA = nA; cB = nB; ++ui;
        if (wr == 1) PG8_BAR;
    }
    PG8_WAIT_V(0);
    PG8_BAR;
#undef PG8_DEPWAIT
#undef PG8_SA
#undef PG8_SB
#undef PG8_STAGE
#undef PG8_LDA
#undef PG8_LDB
#undef PG8_MMA
#undef PG8_WAIT_V
#undef PG8_WAIT_L
#undef PG8_BAR
#undef PG8_SCHED
}

struct TileJob { const float* src; bf16_t* dst; const float* gk; int ld, dstK, k0, n0, dr0; };
__device__ __forceinline__ TileJob decode_tile(const Params& p, int t) {
    TileJob j; int nN, tt, job;
    if (t < 576) { job = 0; tt = t; j.src = p.w_in; j.ld = INW; nN = 36; j.dst = (bf16_t*)(p.ws + WS_WIN); j.dstK = 1024; }
    else if (t < 640) { job = 3; tt = t - 576; j.src = p.w_ck; j.ld = 256; nN = 4; j.dst = (bf16_t*)(p.ws + WS_WCKV); j.dstK = 1024; }
    else if (t < 704) { job = 4; tt = t - 640; j.src = p.w_cv; j.ld = 256; nN = 4; j.dst = (bf16_t*)(p.ws + WS_WCKV); j.dstK = 1024; }
    else if (t < 960) { job = 1; tt = t - 704; j.src = p.w_out; j.ld = 1024; nN = 16; j.dst = (bf16_t*)(p.ws + WS_WOUT); j.dstK = 1024; }
    else if (t < 1024) { job = 2; tt = t - 960; j.src = p.w_cq; j.ld = 256; nN = 4; j.dst = (bf16_t*)(p.ws + WS_WCQ); j.dstK = 1024; }
    else if (t < 1088) { job = 5; tt = t - 1024; j.src = p.w_co; j.ld = 1024; nN = 16; j.dst = (bf16_t*)(p.ws + WS_WCO); j.dstK = 256; }
    else if (t < 1792) { job = 6; tt = t - 1088; j.src = p.w_gate; j.ld = FFN; nN = 44; j.dst = (bf16_t*)(p.ws + WS_WGU); j.dstK = 1024; }
    else if (t < 2496) { job = 7; tt = t - 1792; j.src = p.w_up; j.ld = FFN; nN = 44; j.dst = (bf16_t*)(p.ws + WS_WGU); j.dstK = 1024; }
    else { job = 8; tt = t - 2496; j.src = p.w_down; j.ld = 1024; nN = 16; j.dst = (bf16_t*)(p.ws + WS_WD); j.dstK = FFN; }
    const int kt = tt / nN, ntile = tt % nN; j.n0 = ntile * 64; j.k0 = kt * 64;
    j.dr0 = j.n0;
    if (job == 4) j.dr0 = 256 + j.n0;
    else if (job == 6) j.dr0 = (j.n0 >> 7) * 256 + (j.n0 & 127);
    else if (job == 7) j.dr0 = (j.n0 >> 7) * 256 + 128 + (j.n0 & 127);
    j.gk = (job == 2) ? p.g_cross : ((job == 6 || job == 7) ? p.g_ffn : nullptr);
    return j;
}
constexpr int TILE_F = 64 * 65;
__device__ __forceinline__ void conv_tiles(const Params& p, unsigned char* shm, int t_lo, int t_hi, int w, int nw) {
    const int tid = opaque_tid();
    float* tiles = (float*)shm;
    for (int t0 = t_lo + 4 * w; t0 < t_hi; t0 += 4 * nw) {
#pragma unroll
        for (int q = 0; q < 4; ++q) {
            if (t0 + q < t_hi) { const TileJob j = decode_tile(p, t0 + q); float* tile = tiles + q * TILE_F;
#pragma unroll
                for (int i = 0; i < 8; ++i) { const int kl = (tid >> 6) + 8 * i, nl = tid & 63; const float gs = j.gk ? j.gk[j.k0 + kl] : 1.0f; tile[kl * 65 + nl] = j.src[(size_t)(j.k0 + kl) * j.ld + j.n0 + nl] * gs; } }
        }
        __syncthreads();
#pragma unroll
        for (int q = 0; q < 4; ++q) {
            if (t0 + q < t_hi) { const TileJob j = decode_tile(p, t0 + q); const float* tile = tiles + q * TILE_F;
                const int nl = tid >> 3, kc = tid & 7; float v[8];
#pragma unroll
                for (int jj = 0; jj < 8; ++jj) v[jj] = tile[(kc * 8 + jj) * 65 + nl];
                u32x4 o; o[0] = pk_bf16(v[0], v[1]); o[1] = pk_bf16(v[2], v[3]); o[2] = pk_bf16(v[4], v[5]); o[3] = pk_bf16(v[6], v[7]);
                *(u32x4*)(j.dst + (size_t)(j.dr0 + nl) * j.dstK + j.k0 + kc * 8) = o; }
        }
        __syncthreads();
    }
}
constexpr int T_EARLY = 704, T_MID = 1024, T_ALL = 3200;

__device__ __forceinline__ void phase0(const Params& p, unsigned char* shm, bool all_tiles) {
    const int tid = opaque_tid(), lane = tid & 63, wid = tid >> 6;
    float* wgT = (float*)(shm + 4 * TILE_F * 4);
    for (int idx = tid; idx < 8192; idx += NTHREADS) { const int k = idx >> 3, j = idx & 7; wgT[j * 1024 + k] = p.w_in[(size_t)k * INW + ZW + j]; }
    __syncthreads();
    {
        bf16_t* XN = (bf16_t*)(p.ws + WS_XN); bf16_t* MN = (bf16_t*)(p.ws + WS_MN); float* GT = (float*)(p.ws + WS_GATES);
        for (int rp = blockIdx.x * 8 + wid; rp < (M + 1024) / 2; rp += gridDim.x * 8) {
            const int row0 = 2 * rp;
            const bool ismem = row0 >= M;
            const float* gg = ismem ? p.g_mem : p.g_mix;
            f32x4 v[2][4]; float ss[2];
#pragma unroll
            for (int q = 0; q < 2; ++q) { const int row = row0 + q; const float* src = ismem ? p.mem_prompt + (size_t)(row - M) * D : xrow(p, row);
#pragma unroll
                for (int i = 0; i < 4; ++i) v[q][i] = __builtin_nontemporal_load((const f32x4*)(src + 4 * (lane + 64 * i))); }
            f32x4 gv[4];
#pragma unroll
            for (int i = 0; i < 4; ++i) gv[i] = *(const f32x4*)(gg + 4 * (lane + 64 * i));
#pragma unroll
            for (int q = 0; q < 2; ++q) { float s = 0.f;
#pragma unroll
                for (int i = 0; i < 4; ++i) s += v[q][i][0] * v[q][i][0] + v[q][i][1] * v[q][i][1] + v[q][i][2] * v[q][i][2] + v[q][i][3] * v[q][i][3];
                ss[q] = wave_sum(s); }
#pragma unroll
            for (int q = 0; q < 2; ++q) {
                const int row = row0 + q;
                const float rstd = rsqrtf(ss[q] * (1.0f / D) + 1e-6f);
                bf16_t* dst = ismem ? MN + (size_t)(row - M) * D : XN + (size_t)row * D;
#pragma unroll
                for (int i = 0; i < 4; ++i) { v[q][i] = v[q][i] * rstd * gv[i];
                    u32x2 o; o[0] = pk_bf16(v[q][i][0], v[q][i][1]); o[1] = pk_bf16(v[q][i][2], v[q][i][3]); *(u32x2*)(dst + 4 * (lane + 64 * i)) = o; }
            }
            if (!ismem) {
#pragma unroll
                for (int q = 0; q < 2; ++q) {
                    float a8[8];
#pragma unroll
                    for (int j = 0; j < 8; ++j) { float a = 0.f;
#pragma unroll
                        for (int i = 0; i < 4; ++i) { const f32x4 w = *(const f32x4*)(wgT + j * 1024 + 4 * (lane + 64 * i)); a += v[q][i][0] * w[0] + v[q][i][1] * w[1] + v[q][i][2] * w[2] + v[q][i][3] * w[3]; }
                        a8[j] = a; }
                    const bool h5 = lane & 32, h4 = lane & 16, h3 = lane & 8;
                    float b4[4], c2[2];
#pragma unroll
                    for (int j = 0; j < 4; ++j) { const float snd = h5 ? a8[j] : a8[j + 4]; const float rcv = __shfl_xor(snd, 32); b4[j] = (h5 ? a8[j + 4] : a8[j]) + rcv; }
#pragma unroll
                    for (int j = 0; j < 2; ++j) { const float snd = h4 ? b4[j] : b4[j + 2]; const float rcv = __shfl_xor(snd, 16); c2[j] = (h4 ? b4[j + 2] : b4[j]) + rcv; }
                    float z;
                    { const float snd = h3 ? c2[0] : c2[1]; const float rcv = __shfl_xor(snd, 8); z = (h3 ? c2[1] : c2[0]) + rcv; }
                    z += __shfl_xor(z, 4); z += __shfl_xor(z, 2); z += __shfl_xor(z, 1);
                    if ((lane & 7) == 0) {
                        const int gidx = lane >> 3;
                        float o;
                        if (gidx < 4) o = z + p.b_ig[gidx];
                        else { const float xx = z + p.b_fg[gidx - 4]; o = fminf(xx, 0.f) - log1pf(__expf(-fabsf(xx))); }
                        GT[(size_t)(row0 + q) * 8 + gidx] = o;
                    }
                }
            }
        }
    }
    __syncthreads();
    conv_tiles(p, shm, 0, all_tiles ? T_ALL : T_EARLY, blockIdx.x, gridDim.x);
}

constexpr int KSTR = 72;
template <class MaskF, class FullF>
__device__ __forceinline__ void attn_tiles(const bf16_t* Ks, const bf16_t* Vt, int vstr, const bf16x8 (&Qf)[4], int t0, int t1, float scale_log2, const MaskF& mask, const FullF& full,
                                           f32x16& O0, f32x16& O1, float& m_run, float& l_run) {
    const int lane = threadIdx.x & 63, r = lane & 31, h = lane >> 5;
    for (int t = t0; t < t1; ++t) {
        f32x16 S;
#pragma unroll
        for (int i = 0; i < 16; ++i) S[i] = 0.f;
#pragma unroll
        for (int s = 0; s < 4; ++s) {
            const bf16x8 a = *(const bf16x8*)(Ks + (t * 32 + r) * KSTR + 16 * s + 8 * h);
            __builtin_amdgcn_s_setprio(1);
            S = __builtin_amdgcn_mfma_f32_32x32x16_bf16(a, Qf[s], S, 0, 0, 0);
            __builtin_amdgcn_s_setprio(0);
        }
        float mx = -INFINITY;
        if (full(t)) {
#pragma unroll
            for (int i = 0; i < 16; ++i) mx = fmaxf(mx, S[i]);
        } else {
#pragma unroll
            for (int i = 0; i < 16; ++i) { const int kk = t * 32 + (i & 3) + 8 * (i >> 2) + 4 * h; const float v = mask(kk) ? S[i] : -INFINITY; S[i] = v; mx = fmaxf(mx, v); }
        }
        mx = fmaxf(mx, __shfl_xor(mx, 32));
        const float mn = fmaxf(m_run, mx * scale_log2);
        if (__builtin_amdgcn_ballot_w64(mn != m_run) != 0ull) {
            const float alpha = __builtin_amdgcn_exp2f(m_run - mn);
            l_run *= alpha; m_run = mn;
#pragma unroll
            for (int i = 0; i < 16; ++i) { O0[i] *= alpha; O1[i] *= alpha; }
        }
        float rs = 0.f;
#pragma unroll
        for (int i = 0; i < 16; ++i) { const float pp = __builtin_amdgcn_exp2f(__builtin_fmaf(S[i], scale_log2, -mn)); S[i] = pp; rs += pp; }
        rs += __shfl_xor(rs, 32);
        l_run += rs;
#pragma unroll
        for (int s2 = 0; s2 < 2; ++s2) {
            u32x4 pbu; pbu[0] = pk_bf16(S[8 * s2 + 0], S[8 * s2 + 1]); pbu[1] = pk_bf16(S[8 * s2 + 2], S[8 * s2 + 3]); pbu[2] = pk_bf16(S[8 * s2 + 4], S[8 * s2 + 5]); pbu[3] = pk_bf16(S[8 * s2 + 6], S[8 * s2 + 7]);
            const bf16x8 pb = __builtin_bit_cast(bf16x8, pbu);
            {
                const bf16_t* vp = Vt + (size_t)r * vstr + t * 32 + 16 * s2 + 4 * h;
                u32x4 au; const u32x2 lo = *(const u32x2*)vp, hi = *(const u32x2*)(vp + 8); au[0] = lo[0]; au[1] = lo[1]; au[2] = hi[0]; au[3] = hi[1];
                O0 = __builtin_amdgcn_mfma_f32_32x32x16_bf16(__builtin_bit_cast(bf16x8, au), pb, O0, 0, 0, 0);
            }
            {
                const bf16_t* vp = Vt + (size_t)(32 + r) * vstr + t * 32 + 16 * s2 + 4 * h;
                u32x4 au; const u32x2 lo = *(const u32x2*)vp, hi = *(const u32x2*)(vp + 8); au[0] = lo[0]; au[1] = lo[1]; au[2] = hi[0]; au[3] = hi[1];
                O1 = __builtin_amdgcn_mfma_f32_32x32x16_bf16(__builtin_bit_cast(bf16x8, au), pb, O1, 0, 0, 0);
            }
        }
    }
}
__device__ __forceinline__ void attn_store(bf16_t* dst, const f32x16& O0, const f32x16& O1, float l_run, int h) {
    const float inv = 1.0f / l_run;
    u32x2 a[4], b[4];
#pragma unroll
    for (int g = 0; g < 4; ++g) {
        a[g][0] = pk_bf16(O0[4 * g] * inv, O0[4 * g + 1] * inv); a[g][1] = pk_bf16(O0[4 * g + 2] * inv, O0[4 * g + 3] * inv);
        b[g][0] = pk_bf16(O1[4 * g] * inv, O1[4 * g + 1] * inv); b[g][1] = pk_bf16(O1[4 * g + 2] * inv, O1[4 * g + 3] * inv);
    }
#pragma unroll
    for (int k = 0; k < 2; ++k) {
        {
            const u32x2 snd = h ? a[2 * k] : a[2 * k + 1]; u32x2 rcv;
            rcv[0] = (unsigned)__shfl_xor((int)snd[0], 32); rcv[1] = (unsigned)__shfl_xor((int)snd[1], 32);
            u32x4 o;
            if (h) { o[0] = rcv[0]; o[1] = rcv[1]; o[2] = a[2 * k + 1][0]; o[3] = a[2 * k + 1][1]; } else { o[0] = a[2 * k][0]; o[1] = a[2 * k][1]; o[2] = rcv[0]; o[3] = rcv[1]; }
            *(u32x4*)(dst + 8 * (2 * k + h)) = o;
        }
        {
            const u32x2 snd = h ? b[2 * k] : b[2 * k + 1]; u32x2 rcv;
            rcv[0] = (unsigned)__shfl_xor((int)snd[0], 32); rcv[1] = (unsigned)__shfl_xor((int)snd[1], 32);
            u32x4 o;
            if (h) { o[0] = rcv[0]; o[1] = rcv[1]; o[2] = b[2 * k + 1][0]; o[3] = b[2 * k + 1][1]; } else { o[0] = b[2 * k][0]; o[1] = b[2 * k][1]; o[2] = rcv[0]; o[3] = rcv[1]; }
            *(u32x4*)(dst + 32 + 8 * (2 * k + h)) = o;
        }
    }
}
constexpr float SCALE_LOG2 = 0.125f * 1.4426950408889634f;
constexpr float LOG2E = 1.4426950408889634f;

__device__ __forceinline__ void swa_prompt_unit(const Params& p, unsigned char* shm, int unit) {
    const int tid = opaque_tid(), lane = tid & 63, wid = tid >> 6, r = lane & 31, h = lane >> 5;
    const int n = unit & 31, kvh = (unit >> 5) & 1, b = unit >> 6;
    const int start = n * 128;
    const bf16_t* Z = (const bf16_t*)(p.ws + WS_Z);
    bf16_t* CAT = (bf16_t*)(p.ws + WS_CAT);
    bf16_t* Ks = (bf16_t*)shm;
    bf16_t* Vt = (bf16_t*)(shm + 256 * KSTR * 2);
    constexpr int VSTR = 264;
#pragma unroll
    for (int i = 0; i < 4; ++i) {
        const int idx = tid + 512 * i, key = idx >> 3, ch = idx & 7;
        const int tok = start - 128 + key;
        u32x4 kq = {0u, 0u, 0u, 0u}, vq = {0u, 0u, 0u, 0u};
        if (tok >= 0) { const bf16_t* zr = Z + (size_t)(b * SEQ + tok) * ZW + kvh * 64 + ch * 8; kq = *(const u32x4*)(zr + ZK); vq = *(const u32x4*)(zr + ZV); }
        *(u32x4*)(Ks + key * KSTR + ch * 8) = kq;
#pragma unroll
        for (int j = 0; j < 4; ++j) { Vt[(ch * 8 + 2 * j) * VSTR + key] = (bf16_t)(vq[j] & 0xffffu); Vt[(ch * 8 + 2 * j + 1) * VSTR + key] = (bf16_t)(vq[j] >> 16); }
    }
    __syncthreads();
    const int g = wid >> 1, half = wid & 1, head = kvh * 4 + g;
    const float sink = p.sinks[head] * LOG2E;
    for (int qb = 0; qb < 2; ++qb) {
        const int i0 = half * 64 + qb * 32, qi = i0 + r;
        const int row = b * SEQ + start + qi;
        bf16x8 Qf[4];
#pragma unroll
        for (int s = 0; s < 4; ++s) Qf[s] = *(const bf16x8*)(Z + (size_t)row * ZW + ZQ + head * 64 + 16 * s + 8 * h);
        f32x16 O0, O1;
#pragma unroll
        for (int i = 0; i < 16; ++i) { O0[i] = 0.f; O1[i] = 0.f; }
        float m_run = sink, l_run = 1.0f;
        const int kmin = (start == 0) ? 128 : 0;
        auto mask = [=](int kk) { return kk >= qi && kk <= qi + 128 && kk >= kmin; };
        const int tb = i0 >> 5;
        auto full = [=](int t) { return t > tb && t < tb + 4 && 32 * t >= kmin; };
        attn_tiles(Ks, Vt, VSTR, Qf, tb, tb + 5, SCALE_LOG2, mask, full, O0, O1, m_run, l_run);
        attn_store(CAT + (size_t)row * D + head * 64, O0, O1, l_run, h);
    }
    __syncthreads();
}

__device__ __forceinline__ void swa_sample_unit(const Params& p, unsigned char* shm, int b) {
    const int tid = opaque_tid(), lane = tid & 63, wid = tid >> 6, r = lane & 31, h = lane >> 5;
    const bf16_t* Z = (const bf16_t*)(p.ws + WS_Z);
    bf16_t* CAT = (bf16_t*)(p.ws + WS_CAT);
    constexpr int VSTR = 168, KIMG = 160 * KSTR, VIMG = 64 * VSTR;
    bf16_t* Ks = (bf16_t*)shm;
    bf16_t* Vt = (bf16_t*)(shm + 2 * KIMG * 2);
    float* outk = p.out + O_SKS + (size_t)b * 16384; float* outv = p.out + O_SVS + (size_t)b * 16384;
    const float* ck = p.cache_swa_k + (size_t)b * 16384; const float* cv = p.cache_swa_v + (size_t)b * 16384;
    for (int idx = tid; idx < 2 * 24 * KSTR; idx += NTHREADS) { const int kv = idx / (24 * KSTR), rem = idx % (24 * KSTR); Ks[kv * KIMG + 136 * KSTR + rem] = 0; }
    for (int idx = tid; idx < 2 * 64 * 24; idx += NTHREADS) { const int kv = idx / (64 * 24), rem = idx % (64 * 24), d = rem / 24, kk = rem % 24; Vt[kv * VIMG + d * VSTR + 136 + kk] = 0; }
#pragma unroll
    for (int i = 0; i < 8; ++i) {
        const int idx = tid + 512 * i, j = idx >> 5, c4 = idx & 31, kvh = c4 >> 4, d = (c4 & 15) * 4;
        const f32x4 kq = __builtin_nontemporal_load((const f32x4*)(ck + j * 128 + c4 * 4)), vq = __builtin_nontemporal_load((const f32x4*)(cv + j * 128 + c4 * 4));
        u32x2 o; o[0] = pk_bf16(kq[0], kq[1]); o[1] = pk_bf16(kq[2], kq[3]);
        *(u32x2*)(Ks + kvh * KIMG + j * KSTR + d) = o;
        const unsigned v01 = pk_bf16(vq[0], vq[1]), v23 = pk_bf16(vq[2], vq[3]);
        bf16_t* vb = Vt + kvh * VIMG + d * VSTR + j;
        vb[0] = (bf16_t)(v01 & 0xffffu); vb[VSTR] = (bf16_t)(v01 >> 16); vb[2 * VSTR] = (bf16_t)(v23 & 0xffffu); vb[3 * VSTR] = (bf16_t)(v23 >> 16);
        if (j >= 8) { *(f32x4*)(outk + (j - 8) * 128 + c4 * 4) = kq; *(f32x4*)(outv + (j - 8) * 128 + c4 * 4) = vq; }
    }
    {
        const int e = tid * 2, t = e >> 7, col = e & 127, kvh = col >> 6, d = col & 63;
        const bf16_t* zr = Z + (size_t)(MP + b * 8 + t) * ZW;
        const unsigned kq = *(const unsigned*)(zr + ZK + col), vq = *(const unsigned*)(zr + ZV + col);
        *(unsigned*)(Ks + kvh * KIMG + (128 + t) * KSTR + d) = kq;
        Vt[kvh * VIMG + d * VSTR + 128 + t] = (bf16_t)(vq & 0xffffu); Vt[kvh * VIMG + (d + 1) * VSTR + 128 + t] = (bf16_t)(vq >> 16);
        outk[(120 + t) * 128 + col] = bf_lo(kq); outk[(120 + t) * 128 + col + 1] = bf_hi(kq);
        outv[(120 + t) * 128 + col] = bf_lo(vq); outv[(120 + t) * 128 + col + 1] = bf_hi(vq);
    }
    __syncthreads();
    if (wid < 2) {
        const int kvh = wid, g = r >> 3, t = r & 7, head = kvh * 4 + g;
        const int row = MP + b * 8 + t;
        bf16x8 Qf[4];
#pragma unroll
        for (int s = 0; s < 4; ++s) Qf[s] = *(const bf16x8*)(Z + (size_t)row * ZW + ZQ + head * 64 + 16 * s + 8 * h);
        f32x16 O0, O1;
#pragma unroll
        for (int i = 0; i < 16; ++i) { O0[i] = 0.f; O1[i] = 0.f; }
        float m_run = p.sinks[head] * LOG2E, l_run = 1.0f;
        auto mask = [=](int kk) { return kk >= t && kk <= t + 128; };
        auto full = [=](int tt) { return tt >= 1 && tt <= 3; };
        attn_tiles(Ks + kvh * KIMG, Vt + kvh * VIMG, VSTR, Qf, 0, 5, SCALE_LOG2, mask, full, O0, O1, m_run, l_run);
        attn_store(CAT + (size_t)row * D + head * 64, O0, O1, l_run, h);
    }
    __syncthreads();
}

__device__ __forceinline__ void cross_prompt_unit(const Params& p, unsigned char* shm, int unit) {
    const int tid = opaque_tid(), lane = tid & 63, wid = tid >> 6, r = lane & 31, h = lane >> 5;
    const int qt = unit & 15, head = (unit >> 4) & 3, b = unit >> 6;
    const bf16_t* MKV = (const bf16_t*)(p.ws + WS_MEMKV);
    const bf16_t* Q2 = (const bf16_t*)(p.ws + WS_Q2);
    bf16_t* O2 = (bf16_t*)(p.ws + WS_O2);
    bf16_t* Ks = (bf16_t*)shm; bf16_t* Vt = (bf16_t*)(shm + 256 * KSTR * 2);
    constexpr int VSTR = 264;
#pragma unroll
    for (int i = 0; i < 4; ++i) {
        const int idx = tid + 512 * i, key = idx >> 3, ch = idx & 7;
        const bf16_t* mr = MKV + (size_t)(b * 256 + key) * 512 + head * 64 + ch * 8;
        const u32x4 kq = *(const u32x4*)mr, vq = *(const u32x4*)(mr + 256);
        *(u32x4*)(Ks + key * KSTR + ch * 8) = kq;
#pragma unroll
        for (int j = 0; j < 4; ++j) { Vt[(ch * 8 + 2 * j) * VSTR + key] = (bf16_t)(vq[j] & 0xffffu); Vt[(ch * 8 + 2 * j + 1) * VSTR + key] = (bf16_t)(vq[j] >> 16); }
    }
    __syncthreads();
    const int row = b * SEQ + qt * 256 + wid * 32 + r;
    bf16x8 Qf[4];
#pragma unroll
    for (int s = 0; s < 4; ++s) Qf[s] = *(const bf16x8*)(Q2 + (size_t)row * 256 + head * 64 + 16 * s + 8 * h);
    f32x16 O0, O1;
#pragma unroll
    for (int i = 0; i < 16; ++i) { O0[i] = 0.f; O1[i] = 0.f; }
    float m_run = -1e30f, l_run = 0.f;
    auto mask = [=](int) { return true; };
    attn_tiles(Ks, Vt, VSTR, Qf, 0, 8, SCALE_LOG2, mask, mask, O0, O1, m_run, l_run);
    attn_store(O2 + (size_t)row * 256 + head * 64, O0, O1, l_run, h);
    __syncthreads();
}
__device__ __forceinline__ void cross_sample_unit(const Params& p, unsigned char* shm, int unit) {
    const int tid = opaque_tid(), lane = tid & 63, wid = tid >> 6, r = lane & 31, h = lane >> 5;
    const int head = unit & 3, b = unit >> 2;
    const bf16_t* Q2 = (const bf16_t*)(p.ws + WS_Q2);
    bf16_t* O2 = (bf16_t*)(p.ws + WS_O2);
    bf16_t* Ks = (bf16_t*)shm; bf16_t* Vt = (bf16_t*)(shm + 256 * KSTR * 2);
    constexpr int VSTR = 264;
#pragma unroll
    for (int i = 0; i < 8; ++i) {
        const int idx = tid + 512 * i, key = idx >> 4, c4 = idx & 15, d = c4 * 4;
        const size_t off = ((size_t)(b * 256 + key) * 4 + head) * 64 + d;
        const f32x4 kq = __builtin_nontemporal_load((const f32x4*)(p.cache_mem_k + off)), vq = __builtin_nontemporal_load((const f32x4*)(p.cache_mem_v + off));
        u32x2 o; o[0] = pk_bf16(kq[0], kq[1]); o[1] = pk_bf16(kq[2], kq[3]);
        *(u32x2*)(Ks + key * KSTR + d) = o;
        const unsigned v01 = pk_bf16(vq[0], vq[1]), v23 = pk_bf16(vq[2], vq[3]);
        bf16_t* vb = Vt + d * VSTR + key;
        vb[0] = (bf16_t)(v01 & 0xffffu); vb[VSTR] = (bf16_t)(v01 >> 16); vb[2 * VSTR] = (bf16_t)(v23 & 0xffffu); vb[3 * VSTR] = (bf16_t)(v23 >> 16);
    }
    __syncthreads();
    if (wid == 0) {
        const int t = r & 7, row = MP + b * 8 + t;
        bf16x8 Qf[4];
#pragma unroll
        for (int s = 0; s < 4; ++s) Qf[s] = *(const bf16x8*)(Q2 + (size_t)row * 256 + head * 64 + 16 * s + 8 * h);
        f32x16 O0, O1;
#pragma unroll
        for (int i = 0; i < 16; ++i) { O0[i] = 0.f; O1[i] = 0.f; }
        float m_run = -1e30f, l_run = 0.f;
        auto mask = [=](int) { return true; };
        attn_tiles(Ks, Vt, VSTR, Qf, 0, 8, SCALE_LOG2, mask, mask, O0, O1, m_run, l_run);
        if (r < 8) attn_store(O2 + (size_t)row * 256 + head * 64, O0, O1, l_run, h);
    }
    __syncthreads();
}

__device__ __forceinline__ void unpack8(const u32x4 q, float* v) {
#pragma unroll
    for (int j = 0; j < 4; ++j) { v[2 * j] = bf_lo(q[j]); v[2 * j + 1] = bf_hi(q[j]); }
}
__device__ __forceinline__ void mlstm_scan(const Params& p) {
    const float* SC = (const float*)(p.ws + WS_SCAL); float* MPV = (float*)(p.ws + WS_SCAL) + 2048;
    const bf16_t* UT = (const bf16_t*)(p.ws + WS_UT); const float* NT = (const float*)(p.ws + WS_NT);
    bf16_t* CPREV = (bf16_t*)(p.ws + WS_CPREV); float* NPREV = (float*)(p.ws + WS_NPREV);
    const int tid = opaque_tid();
    for (int base = blockIdx.x * NTHREADS; base < 16 * 8192; base += gridDim.x * NTHREADS) {
        const int bh = base >> 13, elem = (base & 8191) + tid;
        const bool doN = elem < 64;
        float m = 0.f, C = 0.f, n = 0.f;
#pragma unroll 1
        for (int hf = 0; hf < 2; ++hf) {
            const int u0 = bh * 64 + hf * 32;
            float u[32], nn[32];
#pragma unroll
            for (int j = 0; j < 32; ++j) u[j] = bf2f(UT[(size_t)(u0 + j) * 8192 + elem]);
            if (doN) {
#pragma unroll
                for (int j = 0; j < 32; ++j) nn[j] = NT[(u0 + j) * 64 + elem];
            } else {
#pragma unroll
                for (int j = 0; j < 32; ++j) nn[j] = 0.f;
            }
#pragma unroll
            for (int j = 0; j < 32; ++j) {
                const int unit = u0 + j;
                const float A = SC[unit], bL = SC[1024 + unit];
                CPREV[(size_t)unit * 8192 + elem] = (bf16_t)(pk_bf16(C, C) & 0xffffu);
                if (doN) NPREV[unit * 64 + elem] = n;
                if (elem == 0) MPV[unit] = m;
                const float mn = bL + fmaxf(A, m);
                const float wc = __expf(bL + m - mn), g = __expf(A + bL - mn);
                C = wc * C + g * u[j];
                n = wc * n + g * nn[j];
                m = mn;
            }
        }
        p.out[O_CP + (size_t)bh * 8192 + elem] = C;
        if (doN) p.out[O_NP + bh * 64 + elem] = n;
        if (elem == 0) p.out[O_MP + bh] = m;
    }
}

constexpr int MVS = 72;
constexpr int ML_SLOT = 128 * MVS * 2 + 64 * MVS * 2 + 256;
__device__ __forceinline__ void mlstm_local_group(const Params& p, unsigned char* shm, int grp) {
    const int tid = opaque_tid(), lane = tid & 63, wid = tid >> 6, slot = wid >> 1, wq = wid & 1, r = lane & 31, hl = lane >> 5;
    const int unit = grp * 4 + slot, bh = unit >> 6, c = unit & 63, b = bh >> 2, hh = bh & 3;
    const int row0 = b * SEQ + c * 64;
    const bf16_t* Z = (const bf16_t*)(p.ws + WS_Z);
    const float* GT = (const float*)(p.ws + WS_GATES);
    float* SC = (float*)(p.ws + WS_SCAL);
    bf16_t* UT = (bf16_t*)(p.ws + WS_UT); float* NT = (float*)(p.ws + WS_NT);
    bf16_t* Vt = (bf16_t*)(shm + slot * ML_SLOT);
    bf16_t* Kt = Vt + 128 * MVS;
    float* sW = (float*)(Kt + 64 * MVS);
    const float lf = GT[(size_t)(row0 + lane) * 8 + 4 + hh], ig = GT[(size_t)(row0 + lane) * 8 + hh];
    const float bt = wave_scan_add(lf, lane);
    const float a = ig - bt;
    const float A = wave_max(a);
    const float wt = __expf(a - A);
    if (wq == 0) { sW[lane] = wt; if (lane == 63) SC[1024 + unit] = bt; if (lane == 0) SC[unit] = A; }
    const bf16_t* zr = Z + (size_t)(row0 + lane) * ZW;
#pragma unroll
    for (int i = 0; i < 8; ++i) { const int ch = wq + 2 * i; float v[8];
        unpack8(*(const u32x4*)(zr + ZMV + hh * 128 + ch * 8), v);
#pragma unroll
        for (int j = 0; j < 8; j += 2) { const unsigned pk = pk_bf16(v[j] * wt, v[j + 1] * wt); Vt[(ch * 8 + j) * MVS + lane] = (bf16_t)(pk & 0xffffu); Vt[(ch * 8 + j + 1) * MVS + lane] = (bf16_t)(pk >> 16); } }
#pragma unroll
    for (int i = 0; i < 4; ++i) { const int ch = wq + 2 * i; float v[8];
        unpack8(*(const u32x4*)(zr + ZMK + hh * 64 + ch * 8), v);
#pragma unroll
        for (int j = 0; j < 8; j += 2) { const unsigned pk = pk_bf16(v[j] * 0.125f, v[j + 1] * 0.125f); Kt[(ch * 8 + j) * MVS + lane] = (bf16_t)(pk & 0xffffu); Kt[(ch * 8 + j + 1) * MVS + lane] = (bf16_t)(pk >> 16); } }
    __syncthreads();
    f32x16 acc[2][2];
#pragma unroll
    for (int e = 0; e < 2; ++e)
#pragma unroll
        for (int d = 0; d < 2; ++d)
#pragma unroll
            for (int i = 0; i < 16; ++i) acc[e][d][i] = 0.f;
#pragma unroll
    for (int ks = 0; ks < 4; ++ks) {
        bf16x8 Af[2], Bf[2];
#pragma unroll
        for (int e = 0; e < 2; ++e) Af[e] = *(const bf16x8*)(Vt + (32 * (2 * wq + e) + r) * MVS + 16 * ks + 8 * hl);
#pragma unroll
        for (int d = 0; d < 2; ++d) Bf[d] = *(const bf16x8*)(Kt + (32 * d + r) * MVS + 16 * ks + 8 * hl);
#pragma unroll
        for (int e = 0; e < 2; ++e)
#pragma unroll
            for (int d = 0; d < 2; ++d) acc[e][d] = __builtin_amdgcn_mfma_f32_32x32x16_bf16(Af[e], Bf[d], acc[e][d], 0, 0, 0);
    }
#pragma unroll
    for (int e = 0; e < 2; ++e)
#pragma unroll
        for (int d = 0; d < 2; ++d)
#pragma unroll
            for (int i = 0; i < 16; ++i) { const int ee = 32 * (2 * wq + e) + (i & 3) + 8 * (i >> 2) + 4 * hl;
                UT[(size_t)unit * 8192 + ee * 64 + 32 * d + r] = (bf16_t)(pk_bf16(acc[e][d][i], acc[e][d][i]) & 0xffffu); }
    if (wq == 1) { float nn = 0.f;
#pragma unroll 8
        for (int s = 0; s < 64; ++s) nn += sW[s] * bf2f(Kt[lane * MVS + s]);
        NT[(size_t)unit * 64 + lane] = nn; }
    __syncthreads();
}
__device__ __forceinline__ void mlstm_out_group(const Params& p, unsigned char* shm, int grp) {
    const int tid = opaque_tid(), lane = tid & 63, wid = tid >> 6, slot = wid >> 1, qb = wid & 1, r = lane & 31, hl = lane >> 5;
    const int unit = grp * 4 + slot, bh = unit >> 6, c = unit & 63, b = bh >> 2, hh = bh & 3;
    const int row0 = b * SEQ + c * 64;
    const bf16_t* Z = (const bf16_t*)(p.ws + WS_Z);
    const float* GT = (const float*)(p.ws + WS_GATES);
    const float* MPV = (const float*)(p.ws + WS_SCAL) + 2048;
    const bf16_t* CPREV = (const bf16_t*)(p.ws + WS_CPREV) + (size_t)unit * 8192; const float* NPREV = (const float*)(p.ws + WS_NPREV) + unit * 64;
    bf16_t* CAT = (bf16_t*)(p.ws + WS_CAT);
    bf16_t* Vt = (bf16_t*)(shm + slot * ML_SLOT);
    float* sA = (float*)(Vt + 128 * MVS + 64 * MVS);
    const float lf = GT[(size_t)(row0 + lane) * 8 + 4 + hh], ig = GT[(size_t)(row0 + lane) * 8 + hh];
    const float bt = wave_scan_add(lf, lane);
    const float a = ig - bt;
    const float cm = wave_scan_max(a, lane);
    const float mprev = MPV[unit];
    const float mt = bt + fmaxf(cm, mprev);
    const float wi = __expf(bt + mprev - mt);
    if (qb == 0) sA[lane] = a;
    u32x4 ogr[8];
    { const int tp = qb * 64 + lane;
#pragma unroll
      for (int i = 0; i < 8; ++i) { const int idx = tp + 128 * i, orow = idx >> 4, oc = idx & 15; ogr[i] = *(const u32x4*)(Z + (size_t)(row0 + orow) * ZW + ZOG + hh * 128 + oc * 8); } }
    const int l = 32 * qb + r;
    const float bt_l = __shfl(bt, l), mt_l = __shfl(mt, l), wi_l = __shfl(wi, l);
    { const bf16_t* zr = Z + (size_t)(row0 + lane) * ZW + ZMV + hh * 128;
#pragma unroll
      for (int i = 0; i < 8; ++i) { const int ch = qb + 2 * i; const u32x4 q = *(const u32x4*)(zr + ch * 8);
#pragma unroll
          for (int j = 0; j < 4; ++j) { Vt[(ch * 8 + 2 * j) * MVS + lane] = (bf16_t)(q[j] & 0xffffu); Vt[(ch * 8 + 2 * j + 1) * MVS + lane] = (bf16_t)(q[j] >> 16); } } }
    bf16x8 Qf[4]; float qn = 0.f;
#pragma unroll
    for (int ks = 0; ks < 4; ++ks) {
        const u32x4 qq = *(const u32x4*)(Z + (size_t)(row0 + l) * ZW + ZMQ + hh * 64 + 16 * ks + 8 * hl);
        Qf[ks] = __builtin_bit_cast(bf16x8, qq);
        float qv[8]; unpack8(qq, qv);
        const f32x4 n0 = *(const f32x4*)(NPREV + 16 * ks + 8 * hl), n1 = *(const f32x4*)(NPREV + 16 * ks + 8 * hl + 4);
        qn += qv[0] * n0[0] + qv[1] * n0[1] + qv[2] * n0[2] + qv[3] * n0[3] + qv[4] * n1[0] + qv[5] * n1[1] + qv[6] * n1[2] + qv[7] * n1[3];
    }
    qn += __shfl_xor(qn, 32);
    f32x16 O[4];
#pragma unroll
    for (int eb = 0; eb < 4; ++eb) {
#pragma unroll
        for (int i = 0; i < 16; ++i) O[eb][i] = 0.f;
#pragma unroll
        for (int ks = 0; ks < 4; ++ks) {
            const bf16x8 cf = *(const bf16x8*)(CPREV + (32 * eb + r) * 64 + 16 * ks + 8 * hl);
            O[eb] = __builtin_amdgcn_mfma_f32_32x32x16_bf16(cf, Qf[ks], O[eb], 0, 0, 0);
        }
#pragma unroll
        for (int i = 0; i < 16; ++i) O[eb][i] *= wi_l;
    }
    bf16x8 Kf[2][4];
#pragma unroll
    for (int t = 0; t < 2; ++t)
#pragma unroll
        for (int ks = 0; ks < 4; ++ks) Kf[t][ks] = *(const bf16x8*)(Z + (size_t)(row0 + 32 * t + r) * ZW + ZMK + hh * 64 + 16 * ks + 8 * hl);
    __syncthreads();
    float rs = 0.f;
    const float ebase = bt_l - mt_l;
#pragma unroll
    for (int t = 0; t < 2; ++t) {
        if (t > qb) break;
        f32x16 S;
#pragma unroll
        for (int i = 0; i < 16; ++i) S[i] = 0.f;
#pragma unroll
        for (int ks = 0; ks < 4; ++ks) S = __builtin_amdgcn_mfma_f32_32x32x16_bf16(Kf[t][ks], Qf[ks], S, 0, 0, 0);
#pragma unroll
        for (int i = 0; i < 16; ++i) { const int s = 32 * t + (i & 3) + 8 * (i >> 2) + 4 * hl;
            const float w = (s <= l) ? S[i] * 0.125f * __expf(sA[s] + ebase) : 0.f; S[i] = w; rs += w; }
#pragma unroll
        for (int s2 = 0; s2 < 2; ++s2) {
            u32x4 pbu; pbu[0] = pk_bf16(S[8 * s2 + 0], S[8 * s2 + 1]); pbu[1] = pk_bf16(S[8 * s2 + 2], S[8 * s2 + 3]); pbu[2] = pk_bf16(S[8 * s2 + 4], S[8 * s2 + 5]); pbu[3] = pk_bf16(S[8 * s2 + 6], S[8 * s2 + 7]);
            const bf16x8 pb = __builtin_bit_cast(bf16x8, pbu);
#pragma unroll
            for (int eb = 0; eb < 4; ++eb) {
                const bf16_t* vp = Vt + (32 * eb + r) * MVS + t * 32 + 16 * s2 + 4 * hl;
                u32x4 au; const u32x2 lo = *(const u32x2*)vp, hi = *(const u32x2*)(vp + 8); au[0] = lo[0]; au[1] = lo[1]; au[2] = hi[0]; au[3] = hi[1];
                O[eb] = __builtin_amdgcn_mfma_f32_32x32x16_bf16(__builtin_bit_cast(bf16x8, au), pb, O[eb], 0, 0, 0);
            }
        }
    }
    rs += __shfl_xor(rs, 32);
    const float den = rs + wi_l * qn;
    const float inv = 1.0f / fmaxf(fabsf(den), __expf(-mt_l));
    float ss = 0.f;
#pragma unroll
    for (int eb = 0; eb < 4; ++eb)
#pragma unroll
        for (int i = 0; i < 16; ++i) { const float hv = O[eb][i] * inv; O[eb][i] = hv; ss += hv * hv; }
    ss += __shfl_xor(ss, 32);
    const float rstd = rsqrtf(ss * (1.0f / 128.0f) + 1e-6f);
    __syncthreads();
    bf16_t* T = Vt;
    constexpr int TS = 136;
#pragma unroll
    for (int eb = 0; eb < 4; ++eb)
#pragma unroll
        for (int g4 = 0; g4 < 4; ++g4) {
            const int e0 = 32 * eb + 8 * g4 + 4 * hl;
            const f32x4 gh = *(const f32x4*)(p.g_head + hh * 128 + e0);
            u32x2 o; o[0] = pk_bf16(O[eb][4 * g4] * rstd * gh[0], O[eb][4 * g4 + 1] * rstd * gh[1]); o[1] = pk_bf16(O[eb][4 * g4 + 2] * rstd * gh[2], O[eb][4 * g4 + 3] * rstd * gh[3]);
            *(u32x2*)(T + l * TS + e0) = o;
        }
    __syncthreads();
    { const int tp = qb * 64 + lane;
#pragma unroll
      for (int i = 0; i < 8; ++i) { const int idx = tp + 128 * i, orow = idx >> 4, oc = idx & 15;
          const u32x4 pre = *(const u32x4*)(T + orow * TS + oc * 8); const u32x4 og = ogr[i];
          u32x4 o;
#pragma unroll
          for (int k = 0; k < 4; ++k) {
              const float v0 = bf_lo(pre[k]) * __builtin_amdgcn_rcpf(1.0f + __expf(-bf_lo(og[k]))), v1 = bf_hi(pre[k]) * __builtin_amdgcn_rcpf(1.0f + __expf(-bf_hi(og[k])));
              o[k] = pk_bf16(v0, v1); }
          *(u32x4*)(CAT + (size_t)(row0 + orow) * D + 512 + hh * 128 + oc * 8) = o; } }
    __syncthreads();
}

__device__ __forceinline__ void mlstm_sample_group(const Params& p, unsigned char* shm, int b) {
    const int tid = opaque_tid(), hh = tid >> 7, tp = tid & 127, lane = tid & 63, wv = (tid >> 6) & 1;
    const int unit = b * 4 + hh, row0 = MP + b * 8, e = tp;
    const bf16_t* Z = (const bf16_t*)(p.ws + WS_Z);
    const float* GT = (const float*)(p.ws + WS_GATES);
    bf16_t* CAT = (bf16_t*)(p.ws + WS_CAT);
    float* L = (float*)shm + hh * 3584;
    float* qs = L;
    float* ks = qs + 512;
    float* vs = ks + 512;
    float* Ss = vs + 1024;
    float* sm = Ss + 64;
    float* s_a = sm, *s_bt = sm + 8, *s_mt = sm + 16, *s_wi = sm + 24, *s_wk = sm + 32, *s_den = sm + 40, *s_misc = sm + 56;
    float* s_n = sm + 64;
    float* red = s_n + 64;
    f32x4 C4[16];
    { const float* Cin = p.st_C + (size_t)unit * 8192 + e * 64;
#pragma unroll
      for (int i = 0; i < 16; ++i) C4[i] = __builtin_nontemporal_load((const f32x4*)(Cin + 4 * i)); }
#pragma unroll
    for (int i = 0; i < 4; ++i) { const int idx = tp + 128 * i, t = idx >> 6, d = idx & 63; const bf16_t* zr = Z + (size_t)(row0 + t) * ZW;
        qs[idx] = bf2f(zr[ZMQ + hh * 64 + d]); ks[idx] = bf2f(zr[ZMK + hh * 64 + d]) * 0.125f; }
#pragma unroll
    for (int i = 0; i < 8; ++i) { const int idx = tp + 128 * i, t = idx >> 7, ee = idx & 127; vs[idx] = bf2f(Z[(size_t)(row0 + t) * ZW + ZMV + hh * 128 + ee]); }
    if (tp < 64) s_n[tp] = p.st_n[unit * 64 + tp];
    if (tp == 0) {
        const float mprev = p.st_m[unit];
        float bt = 0.f, cm = -INFINITY;
        for (int t = 0; t < 8; ++t) {
            const float lf = GT[(size_t)(row0 + t) * 8 + 4 + hh], ig = GT[(size_t)(row0 + t) * 8 + hh];
            bt += lf; const float a = ig - bt; cm = fmaxf(cm, a);
            const float mt = bt + fmaxf(cm, mprev);
            s_a[t] = a; s_bt[t] = bt; s_mt[t] = mt; s_wi[t] = __expf(bt + mprev - mt);
        }
        const float bL = bt, mnew = s_mt[7];
        for (int t = 0; t < 8; ++t) s_wk[t] = __expf(s_a[t] + bL - mnew);
        s_misc[0] = __expf(bL + mprev - mnew);
        p.out[O_MS + unit] = mnew;
    }
    __syncthreads();
    if (tp < 64) { const int l = tp >> 3, s = tp & 7; float a = 0.f;
#pragma unroll 8
        for (int d = 0; d < 64; ++d) a += qs[l * 64 + d] * ks[s * 64 + d];
        Ss[tp] = (s <= l) ? a * __expf(s_a[s] + s_bt[l] - s_mt[l]) : 0.f; }
    float* n2s = red + 16;
#pragma unroll 1
    for (int l = 0; l < 8; ++l) { float a = 0.f;
#pragma unroll
        for (int i = 0; i < 16; ++i) { const f32x4 q4 = *(const f32x4*)(qs + l * 64 + 4 * i); a += q4[0] * C4[i][0] + q4[1] * C4[i][1] + q4[2] * C4[i][2] + q4[3] * C4[i][3]; }
        n2s[l * 128 + e] = a; }
    __syncthreads();
    if (tp < 8) { float dn = 0.f; for (int s = 0; s < 8; ++s) dn += Ss[tp * 8 + s]; float qn = 0.f;
#pragma unroll 8
        for (int d = 0; d < 64; ++d) qn += qs[tp * 64 + d] * s_n[d];
        dn += s_wi[tp] * qn; s_den[tp] = fmaxf(fabsf(dn), __expf(-s_mt[tp])); }
    float hv[8];
#pragma unroll
    for (int l = 0; l < 8; ++l) { float n1 = 0.f;
#pragma unroll
        for (int s = 0; s < 8; ++s) n1 += Ss[l * 8 + s] * vs[s * 128 + e];
        hv[l] = n1 + s_wi[l] * n2s[l * 128 + e]; }
    __syncthreads();
#pragma unroll
    for (int l = 0; l < 8; ++l) { hv[l] = hv[l] / s_den[l]; const float ss = wave_sum(hv[l] * hv[l]); if (lane == 0) red[l * 2 + wv] = ss; }
    __syncthreads();
#pragma unroll
    for (int l = 0; l < 8; ++l) {
        const float rstd = rsqrtf((red[l * 2] + red[l * 2 + 1]) * (1.0f / 128.0f) + 1e-6f);
        const float og = bf2f(Z[(size_t)(row0 + l) * ZW + ZOG + hh * 128 + e]);
        const float o = hv[l] * rstd * p.g_head[hh * 128 + e] / (1.0f + __expf(-og));
        CAT[(size_t)(row0 + l) * D + 512 + hh * 128 + e] = (bf16_t)(pk_bf16(o, o) & 0xffffu);
    }
    { const float wc = s_misc[0]; float vw[8];
#pragma unroll
      for (int s = 0; s < 8; ++s) vw[s] = s_wk[s] * vs[s * 128 + e];
      float* Cout = p.out + O_CS + (size_t)unit * 8192 + e * 64;
#pragma unroll
      for (int i = 0; i < 16; ++i) { f32x4 c = C4[i] * wc;
#pragma unroll
          for (int s = 0; s < 8; ++s) c += *(const f32x4*)(ks + s * 64 + 4 * i) * vw[s];
          *(f32x4*)(Cout + 4 * i) = c;
          asm volatile("" ::: "memory"); }
      if (tp < 64) { float nn = wc * s_n[tp];
#pragma unroll
          for (int s = 0; s < 8; ++s) nn += s_wk[s] * ks[s * 64 + tp];
          p.out[O_NS + unit * 64 + tp] = nn; } }
    __syncthreads();
}

__device__ __forceinline__ void rms_final(const Params& p) {
    const int tid = opaque_tid(), lane = tid & 63, wid = tid >> 6;
    float* Y = p.out + O_Y;
    const bf16_t* XB = (const bf16_t*)(p.ws + WS_XN);
    const int stride = gridDim.x * 8;
    for (int row0 = blockIdx.x * 8 + wid; row0 < M; row0 += 2 * stride) {
        f32x4 v[2][4];
#pragma unroll
        for (int q = 0; q < 2; ++q) { const int row = row0 + q * stride;
            if (row < M) {
                const bf16_t* xb = XB + (size_t)row * D;
#pragma unroll
                for (int i = 0; i < 4; ++i) { const u32x2 w = *(const u32x2*)(xb + 4 * (lane + 64 * i)); v[q][i] = (f32x4){bf_lo(w[0]), bf_hi(w[0]), bf_lo(w[1]), bf_hi(w[1])}; }
                if (row >= MP) {
                    const bf16_t* sb = (const bf16_t*)(p.ws + WS_SLAB) + (size_t)(row - MP) * D;
#pragma unroll
                    for (int s = 0; s < 11; ++s)
#pragma unroll
                        for (int i = 0; i < 4; ++i) { const u32x2 w = *(const u32x2*)(sb + (size_t)s * MS * D + 4 * (lane + 64 * i)); v[q][i] += (f32x4){bf_lo(w[0]), bf_hi(w[0]), bf_lo(w[1]), bf_hi(w[1])}; }
                }
            } else {
#pragma unroll
                for (int i = 0; i < 4; ++i) v[q][i] = (f32x4){0.f, 0.f, 0.f, 0.f};
            } }
        f32x4 gv[4];
#pragma unroll
        for (int i = 0; i < 4; ++i) gv[i] = *(const f32x4*)(p.g_final + 4 * (lane + 64 * i));
#pragma unroll
        for (int q = 0; q < 2; ++q) { const int row = row0 + q * stride;
            float ss = 0.f;
#pragma unroll
            for (int i = 0; i < 4; ++i) ss += v[q][i][0] * v[q][i][0] + v[q][i][1] * v[q][i][1] + v[q][i][2] * v[q][i][2] + v[q][i][3] * v[q][i][3];
            ss = wave_sum(ss);
            const float rstd = rsqrtf(ss * (1.0f / D) + 1e-6f);
            if (row < M) {
#pragma unroll
                for (int i = 0; i < 4; ++i) __builtin_nontemporal_store(v[q][i] * rstd * gv[i], (f32x4*)(Y + (size_t)row * D + 4 * (lane + 64 * i)));
            } }
    }
}


#define XB_TMO      128
#define XB_XCNT(j)  (256  + 64 * (j))
#define XB_XSUB(j)  (1280 + 64 * (j))
#define XB_XGEN(j)  (2304 + 64 * (j))
#define XB_TOP      3328
#define XB_TOPGEN   3392
#define XCD_BAR_WORDS 3456
#define XB_SPIN_CAP (1u << 18)
__device__ __forceinline__ unsigned xb_ld(unsigned* p)              { return __hip_atomic_load(p, __ATOMIC_RELAXED, __HIP_MEMORY_SCOPE_AGENT); }
__device__ __forceinline__ unsigned xb_add(unsigned* p, unsigned v) { return __hip_atomic_fetch_add(p, v, __ATOMIC_RELAXED, __HIP_MEMORY_SCOPE_AGENT); }
__device__ __forceinline__ unsigned xb_xcc_id() { return (unsigned)__builtin_amdgcn_s_getreg((3 << 11) | 20) & 0xFu; }
#define XB_SPIN(cond, bar) do { unsigned _sp = 0; while (cond) { __builtin_amdgcn_s_sleep(1); \
    if ((++_sp & 255u) == 0u) { if (xb_ld(&(bar)[XB_TMO])) break; if (_sp > XB_SPIN_CAP) { atomicAdd(&(bar)[XB_TMO], 1u); break; } } } } while (0)
struct XcdBarrier { unsigned* bar; unsigned x; volatile LAS unsigned* st; };
__device__ __forceinline__ XcdBarrier xcd_barrier_post(unsigned* bar, volatile LAS unsigned* st) {
    XcdBarrier b; b.bar = bar; b.x = xb_xcc_id(); b.st = st;
    if (threadIdx.x == 0) (void)xb_add(&bar[XB_XCNT(b.x)], 1u);
    return b;
}
__device__ __forceinline__ void xcd_barrier_complete(unsigned* bar, unsigned x, unsigned& nloc, unsigned& nx) {
    const unsigned G = gridDim.x * gridDim.y * gridDim.z;
    unsigned sum, cnt, mine, sp = 0u;
    for (;;) {
        sum = 0u; cnt = 0u; mine = 0u;
#pragma unroll
        for (unsigned j = 0; j < 16; ++j) { const unsigned c = xb_ld(&bar[XB_XCNT(j)]); sum += c; cnt += (c > 0u) ? 1u : 0u; mine = (j == x) ? c : mine; }
        if (sum == G) break;
        __builtin_amdgcn_s_sleep(1);
        if ((++sp & 255u) == 0u) { if (xb_ld(&bar[XB_TMO])) break; if (sp > XB_SPIN_CAP) { atomicAdd(&bar[XB_TMO], 1u); break; } }
    }
    nloc = mine > 0u ? mine : 1u; nx = cnt > 0u ? cnt : 1u;
}
__device__ __forceinline__ void xcd_barrier(const XcdBarrier& b) {
    asm volatile("s_waitcnt vmcnt(0)" ::: "memory");
    __syncthreads();
    if (threadIdx.x == 0) {
        unsigned* bar = b.bar;
        __builtin_amdgcn_s_waitcnt(0);
        unsigned nloc = b.st[0], nx = b.st[1];
        if (nloc == 0u) { xcd_barrier_complete(bar, b.x, nloc, nx); b.st[0] = nloc; b.st[1] = nx; }
        const unsigned old = xb_add(&bar[XB_XSUB(b.x)], 1u);
        const unsigned gen = old / nloc;
        if (old + 1u == (gen + 1u) * nloc) {
            __builtin_amdgcn_fence(__ATOMIC_RELEASE, "agent");
            asm volatile("s_waitcnt vmcnt(0)" ::: "memory");
            const unsigned og = xb_add(&bar[XB_TOP], 1u);
            const unsigned tg = og / nx;
            if (og + 1u == (tg + 1u) * nx) xb_add(&bar[XB_TOPGEN], 1u);
            else XB_SPIN(xb_ld(&bar[XB_TOPGEN]) == tg, bar);
            __builtin_amdgcn_fence(__ATOMIC_ACQUIRE, "agent");
            xb_add(&bar[XB_XGEN(b.x)], 1u);
            asm volatile("s_waitcnt vmcnt(0)" ::: "memory");
        } else {
            XB_SPIN(xb_ld(&bar[XB_XGEN(b.x)]) == gen, bar);
            __builtin_amdgcn_fence(__ATOMIC_ACQUIRE, "agent");
            asm volatile("s_waitcnt vmcnt(0)" ::: "memory");
        }
    }
    __syncthreads();
}

__global__ void __launch_bounds__(NTHREADS, 2) fwd_megakernel(Params p) {
    extern __shared__ __attribute__((aligned(16))) unsigned char shm[];
    cg::grid_group grid = cg::this_grid();
    const int G = gridDim.x, bid = blockIdx.x, tid = threadIdx.x;
    bf16_t* XN = (bf16_t*)(p.ws + WS_XN);

    volatile LAS unsigned* xst = (volatile LAS unsigned*)((LAS unsigned char*)shm + LDS_BYTES - 16);
    if (tid == 0) { xst[0] = 0u; xst[1] = 0u; }
    __syncthreads();
    const XcdBarrier xbar = xcd_barrier_post((unsigned*)(p.ws + WS_BAR), xst);
    const bool late_tiles = (G == 256);
    phase0(p, shm, !late_tiles);
    if (p.out == nullptr) grid.sync();
    xcd_barrier(xbar);
#define RUN_GEMM(GG, EE, CSH) do { const pg8::Gemm g_ = GG; const Epi E_ = EE; pg8::StaticOrder S_; S_.init(g_.M, g_.N, G, (bid + (CSH)) % G); gemm_phase(p, (LAS unsigned char*)shm, g_, S_, E_); } while (0)
    RUN_GEMM((pg8::Gemm{XN, (const bf16_t*)(p.ws + WS_WIN), M, ZW, D, D}), (Epi{EM_BF16, 1, ZW, (bf16_t*)(p.ws + WS_Z), nullptr, nullptr, nullptr}), 0);
    RUN_GEMM((pg8::Gemm{(const bf16_t*)(p.ws + WS_MN), (const bf16_t*)(p.ws + WS_WCKV), 1024, 512, D, D}), (Epi{EM_MEMKV, 0, 512, (bf16_t*)(p.ws + WS_MEMKV), nullptr, nullptr, nullptr}), 128);
    if (late_tiles && bid >= 100 && !(bid >= 128 && bid < 136)) conv_tiles(p, shm, T_EARLY, T_MID, bid < 128 ? bid - 100 : bid - 108, 148);
    xcd_barrier(xbar);
    {
        for (int u = bid; u < 256; u += G) swa_prompt_unit(p, shm, u);
        for (int u = bid; u < NUNIT / 4; u += G) mlstm_local_group(p, shm, u);
        for (int u = bid; u < 256; u += G) { if (u < 128) mlstm_sample_group(p, shm, u); else swa_sample_unit(p, shm, u - 128); }
        const bf16_t* Z = (const bf16_t*)(p.ws + WS_Z);
        for (int idx = bid * NTHREADS + tid; idx < 4 * 128 * 128; idx += G * NTHREADS) {
            const int col = idx & 127, j = (idx >> 7) & 127, b = idx >> 14;
            const bf16_t* zr = Z + (size_t)(b * SEQ + SEQ - 128 + j) * ZW;
            p.out[O_SKP + idx] = bf2f(zr[ZK + col]); p.out[O_SVP + idx] = bf2f(zr[ZV + col]); }
    }
    xcd_barrier(xbar);
    mlstm_scan(p);
    xcd_barrier(xbar);
    for (int u = bid; u < NUNIT / 4; u += G) mlstm_out_group(p, shm, u);
    xcd_barrier(xbar);
    float* SSQ1 = (float*)(p.ws + WS_SSQ1); float* SSQ2 = (float*)(p.ws + WS_SSQ2);
    RUN_GEMM((pg8::Gemm{(const bf16_t*)(p.ws + WS_CAT), (const bf16_t*)(p.ws + WS_WOUT), M, D, D, D}), (Epi{EM_RES_X, 1, D, XN, nullptr, nullptr, SSQ1}), 0);
    xcd_barrier(xbar);
    RUN_GEMM((pg8::Gemm{XN, (const bf16_t*)(p.ws + WS_WCQ), M, 256, D, D}), (Epi{EM_BF16, 1, 256, (bf16_t*)(p.ws + WS_Q2), nullptr, nullptr, SSQ1}), 0);
    if (late_tiles && bid >= 68) conv_tiles(p, shm, T_MID, T_ALL, bid - 68, 188);
    xcd_barrier(xbar);
    {
        for (int u = bid; u < 256; u += G) cross_prompt_unit(p, shm, u);
        for (int u = bid; u < 512; u += G) cross_sample_unit(p, shm, u);
    }
    xcd_barrier(xbar);
    const bool split_co = (G == 256);
    RUN_GEMM((pg8::Gemm{(const bf16_t*)(p.ws + WS_O2), (const bf16_t*)(p.ws + WS_WCO), split_co ? MP : M, D, 256, 256}), (Epi{EM_RES_Y, 1, D, XN, nullptr, nullptr, SSQ2}), 0);
    xcd_barrier(xbar);
    unsigned* DEP = (unsigned*)(p.ws + WS_DEP);
    if (split_co && bid >= 240) {
        const int tl = bid - 240;
        const pg8::Gemm g_ = {(const bf16_t*)(p.ws + WS_O2), (const bf16_t*)(p.ws + WS_WCO), M, D, 256, 256};
        const Epi E_ = {EM_RES_Y, 1, D, XN, nullptr, nullptr, SSQ2};
        pg8::StaticOrder S_; S_.init(M, D, G, 0); S_.spm = 64 + (tl >> 2); S_.spn = tl & 3;
        gemm_phase(p, (LAS unsigned char*)shm, g_, S_, E_);
        asm volatile("s_waitcnt vmcnt(0)" ::: "memory");
        __syncthreads();
        if (tid == 0) { __builtin_amdgcn_fence(__ATOMIC_RELEASE, "agent"); asm volatile("s_waitcnt vmcnt(0)" ::: "memory");
            (void)__hip_atomic_fetch_add(DEP, 1u, __ATOMIC_RELAXED, __HIP_MEMORY_SCOPE_AGENT); }
    }
    RUN_GEMM((pg8::Gemm{XN, (const bf16_t*)(p.ws + WS_WGU), M, 2 * FFN, D, D}), (Epi{EM_SWIGLU, 1, FFN, (bf16_t*)(p.ws + WS_H), nullptr, split_co ? DEP : nullptr, SSQ2}), 0);
    xcd_barrier(xbar);
    RUN_GEMM((pg8::Gemm{(const bf16_t*)(p.ws + WS_H), (const bf16_t*)(p.ws + WS_WD), MP, D, FFN, FFN}), (Epi{EM_RES_Y, 1, D, XN, nullptr, nullptr, nullptr}), 0);
    {
        const int su = (bid + 80) % G;
        const int sl = su >> 4, tl = su & 15;
        const pg8::Gemm g_ = {(const bf16_t*)(p.ws + WS_H) + sl * 256, (const bf16_t*)(p.ws + WS_WD) + sl * 256, M, D, 256, FFN};
        const Epi E_ = {EM_SLAB, 0, D, nullptr, (float*)((bf16_t*)(p.ws + WS_SLAB) + (size_t)sl * MS * D), nullptr, nullptr};
        pg8::StaticOrder S_; S_.init(M, D, G, su < 176 ? 0 : -1); S_.spm = 64 + (tl >> 2); S_.spn = tl & 3;
        gemm_phase(p, (LAS unsigned char*)shm, g_, S_, E_);
    }
    xcd_barrier(xbar);
    rms_final(p);
}

extern "C" void kernel_launch(void* const* d_in, const int* in_sizes, int n_in, void* d_out, int out_size, void* d_ws, size_t ws_size, hipStream_t stream) {
    static int grid = 0;
    if (grid == 0) {
        int dev = 0, cus = 0, per_cu = 0;
        (void)hipGetDevice(&dev);
        (void)hipDeviceGetAttribute(&cus, hipDeviceAttributeMultiprocessorCount, dev);
        (void)hipFuncSetAttribute((const void*)fwd_megakernel, hipFuncAttributeMaxDynamicSharedMemorySize, LDS_BYTES);
        (void)hipOccupancyMaxActiveBlocksPerMultiprocessor(&per_cu, (const void*)fwd_megakernel, NTHREADS, LDS_BYTES);
        if (per_cu < 1) per_cu = 1;
        if (per_cu > 1) per_cu = 1;
        grid = cus * per_cu;
        if (ws_size < WS_END || n_in != 28 || (size_t)out_size != O_END) fprintf(stderr, "kernel_launch: unexpected sizes ws %zu (need %zu) n_in %d out %d\n", ws_size, (size_t)WS_END, n_in, out_size);
    }
    Params p{};
    const float** pp = (const float**)&p;
    for (int i = 0; i < 28; ++i) pp[i] = (const float*)d_in[i];
    p.out = (float*)d_out; p.ws = (unsigned char*)d_ws;
    (void)hipMemsetAsync((unsigned char*)d_ws + WS_BAR, 0, WS_ZERO_BYTES, stream);
    void* args[] = {&p};
    hipError_t e = hipLaunchCooperativeKernel((const void*)fwd_megakernel, dim3(grid), dim3(NTHREADS), args, LDS_BYTES, stream);
    if (e != hipSuccess) fprintf(stderr, "cooperative launch failed: %s (grid %d)\n", hipGetErrorString(e), grid);
}
```
